# Optimizing an MI355X kernel written in HIP

```python
import jax, jax.numpy as jnp
from jax import lax
import numpy as np

D_MODEL = 2048
BATCH = 4
SEQ = 8192
DEPTH = 1
DEC_BATCH = 8
DEC_SEQ = 32
PAST_LEN = 2048

CHUNK = 64
N_SUB = 3
FFN_RES = 0.5
D_FF = 5632
GMLP_CHUNK = 128
D_A = D_MODEL // 2
N_GROUPS_A = 8
GROUP_A = D_A // N_GROUPS_A
HEAD_DIM = 64
N_HEADS = (D_MODEL // 2) // HEAD_DIM
N_KV_HEADS = 4
Q_PER_KV = N_HEADS // N_KV_HEADS
D_B = N_HEADS * HEAD_DIM
D_KV = N_KV_HEADS * HEAD_DIM
WINDOW = 128
WINDOW_CHUNKS = WINDOW // CHUNK
BAND = (WINDOW_CHUNKS + 1) * CHUNK
ROT_DIM = HEAD_DIM // 4
ROPE_THETA = 500000.0
ATTN_SCALE = HEAD_DIM ** -0.5
NEG_INF = -1e30
EPS = 1e-6
SPLITS = (D_A, 2 * D_A, 2 * D_A + D_B, 2 * D_A + D_B + D_KV, 2 * D_A + D_B + 2 * D_KV,
          2 * D_A + D_B + 2 * D_KV + D_MODEL)
D_IN = 2 * D_A + D_B + 2 * D_KV + 2 * D_MODEL

kernel_name = 'chunk_stream_gmlp_swa_hybrid'


def _rmsnorm(x, g):
    xf = x.astype(jnp.float32)
    y = xf * lax.rsqrt(jnp.mean(xf * xf, axis=-1, keepdims=True) + EPS)
    return (y * g.astype(jnp.float32)).astype(x.dtype)


def _layernorm(x, g, b):
    xf = x.astype(jnp.float32)
    mu = jnp.mean(xf, axis=-1, keepdims=True)
    var = jnp.mean(jnp.square(xf - mu), axis=-1, keepdims=True)
    y = (xf - mu) * lax.rsqrt(var + EPS)
    return (y * g.astype(jnp.float32) + b.astype(jnp.float32)).astype(x.dtype)


def _adaln(c, w_ada, b_ada):
    mod = jax.nn.silu(c) @ w_ada + b_ada
    return mod.reshape(c.shape[0], N_SUB, 3, D_MODEL)


def _modulate(h, shift, scale):
    return h * (1 + scale[:, None, :]) + shift[:, None, :]


def _ffn_half(x, mod, g, w1, w3, w2):
    h = _modulate(_rmsnorm(x, g), mod[:, 0], mod[:, 1])
    y = (jax.nn.silu(h @ w1) * (h @ w3)) @ w2
    return x + FFN_RES * mod[:, 2][:, None, :] * y


def _rope(x, pos):
    inv_freq = ROPE_THETA ** (-jnp.arange(0, ROT_DIM, 2, dtype=jnp.float32) / ROT_DIM)
    ang = pos.astype(jnp.float32)[:, None] * inv_freq[None, :]
    cos = jnp.cos(ang)[:, None, :]
    sin = jnp.sin(ang)[:, None, :]
    xr = x[..., :ROT_DIM].astype(jnp.float32)
    x1, x2 = xr[..., :ROT_DIM // 2], xr[..., ROT_DIM // 2:]
    rot = jnp.concatenate([x1 * cos - x2 * sin, x2 * cos + x1 * sin], axis=-1).astype(x.dtype)
    return jnp.concatenate([rot, x[..., ROT_DIM:]], axis=-1)


def _mixer_inputs(x, mod, lw, pos):
    b, s, _ = x.shape
    h = _modulate(_rmsnorm(x, lw['g_mix']), mod[:, 0], mod[:, 1])
    proj = h @ lw['w_in']
    u, v, q, k, va, ga, gb = jnp.split(proj, SPLITS, axis=-1)
    u = jax.nn.gelu(u, approximate=False)
    v_n = _layernorm(jax.nn.gelu(v, approximate=False), lw['ln_v_g'], lw['ln_v_b'])
    q = _rope(_rmsnorm(q.reshape(b, s, N_HEADS, HEAD_DIM), lw['g_q']), pos)
    k = _rope(_rmsnorm(k.reshape(b, s, N_KV_HEADS, HEAD_DIM), lw['g_k']), pos)
    va = va.reshape(b, s, N_KV_HEADS, HEAD_DIM)
    return u, v_n, q, k, va, ga, gb


def _gmlp_mask(dtype):
    i = np.arange(GMLP_CHUNK)
    return jnp.asarray((i[None, :] // CHUNK) <= (i[:, None] // CHUNK), dtype=dtype)


def _spatial_gate(u, v_n, w_s, b_s):
    b, s, _ = u.shape
    l = min(s, GMLP_CHUNK)
    w = (w_s * _gmlp_mask(w_s.dtype))[:, :l, :l]
    vb = v_n.reshape(b, s // l, l, N_GROUPS_A, GROUP_A)
    sv = jnp.einsum('gij,bnjgc->bnigc', w, vb) + b_s[:, :l].T[None, None, :, :, None]
    return u * sv.reshape(b, s, D_A)


def _sink_attend(qb, kb, vb, sinks, valid):
    s = jnp.einsum('bnqhgd,bnkhd->bnhgqk', qb, kb).astype(jnp.float32) * ATTN_SCALE
    s = jnp.where(valid[None, :, None, None, None, :], s, NEG_INF)
    sink = sinks.astype(jnp.float32).reshape(N_KV_HEADS, Q_PER_KV)[None, None, :, :, None, None]
    sink = jnp.broadcast_to(sink, s.shape[:-1] + (1,))
    p = jax.nn.softmax(jnp.concatenate([s, sink], axis=-1), axis=-1)[..., :-1]
    return jnp.einsum('bnhgqk,bnkhd->bnqhgd', p.astype(vb.dtype), vb)


def _swa_prompt(q, k, v, sinks):
    b, s = q.shape[:2]
    nc = s // CHUNK
    pad = WINDOW_CHUNKS * CHUNK

    def band(t):
        tp = jnp.pad(t, ((0, 0), (pad, 0), (0, 0), (0, 0)))
        tp = tp.reshape(b, nc + WINDOW_CHUNKS, CHUNK, N_KV_HEADS, HEAD_DIM)
        return jnp.concatenate([tp[:, i:i + nc] for i in range(WINDOW_CHUNKS + 1)], axis=2)

    key_pos = jnp.arange(nc)[:, None] * CHUNK + jnp.arange(BAND)[None, :] - pad
    qb = q.reshape(b, nc, CHUNK, N_KV_HEADS, Q_PER_KV, HEAD_DIM)
    o = _sink_attend(qb, band(k), band(v), sinks, key_pos >= 0)
    return o.reshape(b, s, D_B)


def _swa_sample(q, k, v, cache_k, cache_v, sinks):
    b, n = q.shape[:2]
    k_all = jnp.concatenate([cache_k.astype(k.dtype), k], axis=1)
    v_all = jnp.concatenate([cache_v.astype(v.dtype), v], axis=1)
    valid = jnp.ones((1, k_all.shape[1]), dtype=bool)
    qb = q.reshape(b, 1, n, N_KV_HEADS, Q_PER_KV, HEAD_DIM)
    o = _sink_attend(qb, k_all[:, None], v_all[:, None], sinks, valid)
    win = cache_k.shape[1]
    return o.reshape(b, n, D_B), k_all[:, -win:], v_all[:, -win:]


def _merge(x, mod, a, o, ga, gb, lw):
    y = jax.nn.sigmoid(ga) * (a @ lw['w_pa']) + jax.nn.sigmoid(gb) * (o @ lw['w_pb'])
    return x + mod[:, 2][:, None, :] * (y @ lw['w_o'])


def _layer_prompt(x, c, lw):
    mod = _adaln(c, lw['w_ada'], lw['b_ada'])
    x = _ffn_half(x, mod[:, 0], lw['g_ffn1'], lw['w1_ffn1'], lw['w3_ffn1'], lw['w2_ffn1'])
    pos = jnp.arange(x.shape[1])
    u, v_n, q, k, v, ga, gb = _mixer_inputs(x, mod[:, 1], lw, pos)
    a = _spatial_gate(u, v_n, lw['w_s'], lw['b_s'])
    o = _swa_prompt(q, k, v, lw['sinks'])
    x = _merge(x, mod[:, 1], a, o, ga, gb, lw)
    x = _ffn_half(x, mod[:, 2], lw['g_ffn2'], lw['w1_ffn2'], lw['w3_ffn2'], lw['w2_ffn2'])
    return x, k, v


def _layer_sample(x, c, cache_k, cache_v, lw):
    mod = _adaln(c, lw['w_ada'], lw['b_ada'])
    x = _ffn_half(x, mod[:, 0], lw['g_ffn1'], lw['w1_ffn1'], lw['w3_ffn1'], lw['w2_ffn1'])
    pos = PAST_LEN + jnp.arange(x.shape[1])
    u, v_n, q, k, v, ga, gb = _mixer_inputs(x, mod[:, 1], lw, pos)
    a = _spatial_gate(u, v_n, lw['w_s'], lw['b_s'])
    o, k_win, v_win = _swa_sample(q, k, v, cache_k, cache_v, lw['sinks'])
    x = _merge(x, mod[:, 1], a, o, ga, gb, lw)
    x = _ffn_half(x, mod[:, 2], lw['g_ffn2'], lw['w1_ffn2'], lw['w3_ffn2'], lw['w2_ffn2'])
    return x, k_win, v_win, v_n


def setup_inputs(seed: int = 0) -> dict:
    key = jax.random.key(seed)
    ks = jax.random.split(key, 28)

    def nrm(k, shape, scale):
        return jax.random.normal(k, shape, jnp.float32) * scale

    win = min(WINDOW, PAST_LEN)
    L = DEPTH
    return {
        'x_prompt': nrm(ks[0], (BATCH, SEQ, D_MODEL), 1.0),
        'x_sample': nrm(ks[1], (DEC_BATCH, DEC_SEQ, D_MODEL), 1.0),
        'cache_swa_k': nrm(ks[2], (L, DEC_BATCH, win, N_KV_HEADS, HEAD_DIM), 1.0),
        'cache_swa_v': nrm(ks[3], (L, DEC_BATCH, win, N_KV_HEADS, HEAD_DIM), 1.0),
        'c_prompt': nrm(ks[4], (BATCH, D_MODEL), 1.0),
        'c_sample': nrm(ks[5], (DEC_BATCH, D_MODEL), 1.0),
        'w_ada': nrm(ks[6], (L, D_MODEL, N_SUB * 3 * D_MODEL), 0.5 * D_MODEL ** -0.5),
        'b_ada': nrm(ks[7], (L, N_SUB * 3 * D_MODEL), 0.02),
        'g_ffn1': 1.0 + nrm(ks[8], (L, D_MODEL), 0.05),
        'w1_ffn1': nrm(ks[9], (L, D_MODEL, D_FF), D_MODEL ** -0.5),
        'w3_ffn1': nrm(ks[10], (L, D_MODEL, D_FF), D_MODEL ** -0.5),
        'w2_ffn1': nrm(ks[11], (L, D_FF, D_MODEL), D_FF ** -0.5),
        'g_mix': 1.0 + nrm(ks[12], (L, D_MODEL), 0.05),
        'w_in': nrm(ks[13], (L, D_MODEL, D_IN), D_MODEL ** -0.5),
        'g_q': 1.0 + nrm(ks[14], (L, HEAD_DIM), 0.05),
        'g_k': 1.0 + nrm(ks[15], (L, HEAD_DIM), 0.05),
        'ln_v_g': 1.0 + nrm(ks[16], (L, D_A), 0.05),
        'ln_v_b': nrm(ks[17], (L, D_A), 0.02),
        'w_s': nrm(ks[18], (L, N_GROUPS_A, GMLP_CHUNK, GMLP_CHUNK), GMLP_CHUNK ** -0.5),
        'b_s': 1.0 + nrm(ks[19], (L, N_GROUPS_A, GMLP_CHUNK), 0.05),
        'sinks': nrm(ks[20], (L, N_HEADS), 0.5),
        'w_pa': nrm(ks[21], (L, D_A, D_MODEL), D_A ** -0.5),
        'w_pb': nrm(ks[22], (L, D_B, D_MODEL), D_B ** -0.5),
        'w_o': nrm(ks[23], (L, D_MODEL, D_MODEL), D_MODEL ** -0.5),
        'g_ffn2': 1.0 + nrm(ks[24], (L, D_MODEL), 0.05),
        'w1_ffn2': nrm(ks[25], (L, D_MODEL, D_FF), D_MODEL ** -0.5),
        'w3_ffn2': nrm(ks[26], (L, D_MODEL, D_FF), D_MODEL ** -0.5),
        'w2_ffn2': nrm(ks[27], (L, D_FF, D_MODEL), D_FF ** -0.5),
    }


def reference(x_prompt, x_sample, cache_swa_k, cache_swa_v, c_prompt, c_sample, w_ada, b_ada,
              g_ffn1, w1_ffn1, w3_ffn1, w2_ffn1, g_mix, w_in, g_q, g_k, ln_v_g, ln_v_b, w_s, b_s,
              sinks, w_pa, w_pb, w_o, g_ffn2, w1_ffn2, w3_ffn2, w2_ffn2):
    win = cache_swa_k.shape[2]
    y_p, y_s = x_prompt, x_sample
    kp_l, vp_l, ks_l, vs_l, gv_l = [], [], [], [], []
    for l in range(DEPTH):
        lw = {'w_ada': w_ada[l], 'b_ada': b_ada[l],
              'g_ffn1': g_ffn1[l], 'w1_ffn1': w1_ffn1[l], 'w3_ffn1': w3_ffn1[l], 'w2_ffn1': w2_ffn1[l],
              'g_mix': g_mix[l], 'w_in': w_in[l], 'g_q': g_q[l], 'g_k': g_k[l],
              'ln_v_g': ln_v_g[l], 'ln_v_b': ln_v_b[l], 'w_s': w_s[l], 'b_s': b_s[l],
              'sinks': sinks[l], 'w_pa': w_pa[l], 'w_pb': w_pb[l], 'w_o': w_o[l],
              'g_ffn2': g_ffn2[l], 'w1_ffn2': w1_ffn2[l], 'w3_ffn2': w3_ffn2[l], 'w2_ffn2': w2_ffn2[l]}
        y_p, k_p, v_p = _layer_prompt(y_p, c_prompt, lw)
        y_s, k_s, v_s, vn_s = _layer_sample(y_s, c_sample, cache_swa_k[l], cache_swa_v[l], lw)
        kp_l.append(k_p[:, -win:])
        vp_l.append(v_p[:, -win:])
        ks_l.append(k_s)
        vs_l.append(v_s)
        gv_l.append(vn_s)
    swa_k_prompt = jnp.stack(kp_l)
    swa_v_prompt = jnp.stack(vp_l)
    swa_k_sample = jnp.stack(ks_l)
    swa_v_sample = jnp.stack(vs_l)
    gmlp_v_sample = jnp.stack(gv_l)
    return (y_p, y_s, swa_k_prompt, swa_v_prompt, swa_k_sample, swa_v_sample, gmlp_v_sample)
```

```cpp
#include <hip/hip_runtime.h>
#include <hip/hip_cooperative_groups.h>
#include <cstdio>
#include <cstdint>
namespace cg = cooperative_groups;

#ifndef MK_N_LAUNCHES
#define MK_N_LAUNCHES 1
#endif

namespace pg8 {
#define PG8_LAS __attribute__((address_space(3)))
typedef unsigned short bf16_t;
typedef short bf16x8 __attribute__((ext_vector_type(8)));
typedef float f32x4 __attribute__((ext_vector_type(4)));
typedef float f32x2 __attribute__((ext_vector_type(2)));
typedef unsigned u32x4 __attribute__((ext_vector_type(4)));
typedef unsigned u32x2 __attribute__((ext_vector_type(2)));
constexpr int BM = 256, BK = 64, HALF = 128, HTB = HALF * BK * 2, STAGE_BYTES = 8 * HTB, NXCD = 8, WGM = 8;

__host__ __device__ __forceinline__ int lds_byte(int r, int c) { const int st = (r >> 4) * 2 + (c >> 5), rr = r & 15, cc = c & 31, ob = rr * 64 + cc * 2; return st * 1024 + (ob ^ (((ob >> 9) & 1) << 5)); }
__host__ __device__ __forceinline__ void stage_rc(int b, int& R, int& C) { const int st = b / 1024, sb = b % 1024, swz = sb ^ (((sb >> 9) & 1) << 5); R = (st >> 1) * 16 + swz / 64; C = (st & 1) * 32 + (swz % 64) / 2; }
__host__ __device__ __forceinline__ int perm32(int rho) { const int n = rho >> 4, i = rho & 15; return 8 * (i >> 2) + 4 * n + (i & 3); }

struct Unit { int pm, pn; };
struct Gemm { const bf16_t* A; const bf16_t* Bt; int M, N, K, lda, ldb; };

struct StaticOrder {
    int nM, nN, nwg, G, c;
    __host__ __device__ void init(int M, int N, int G_, int c_) { nM = M / BM; nN = N / BM; nwg = nM * nN; G = G_; c = c_; }
    __host__ __device__ bool next(int i, Unit& u) const {
        const long L = (long)i * G + c; if (L >= nwg) return false;
        int wgid = (int)L; { const int q = nwg / NXCD, r = nwg % NXCD, xcd = wgid % NXCD, off = wgid / NXCD; wgid = (xcd < r ? xcd * (q + 1) : r * (q + 1) + (xcd - r) * q) + off; }
        const int nig = WGM * nN, gid = wgid / nig, fm = gid * WGM, gsz = (nM - fm) < WGM ? (nM - fm) : WGM;
        u.pm = fm + ((wgid % nig) % gsz); u.pn = (wgid % nig) / gsz; return true;
    }
};

__device__ __forceinline__ unsigned cvt_pk_bf16(float lo, float hi) { unsigned r; asm volatile("v_cvt_pk_bf16_f32 %0, %1, %2" : "=v"(r) : "v"(lo), "v"(hi)); return r; }
__device__ __forceinline__ f32x2 gelu_pk(f32x2 v) {
    const f32x2 av = __builtin_elementwise_abs(v), d = av * 0.2316418882f + 1.0f;
    f32x2 t; t.x = __builtin_amdgcn_rcpf(d.x); t.y = __builtin_amdgcn_rcpf(d.y);
    f32x2 q = t * 0.5307027145f + (-0.7265760135f); q = q * t + 0.7107068705f; q = q * t + (-0.142248368f); q = q * t + 0.127414796f; q = q * t;
    const f32x2 s = (v * v) * (-0.72134752044f);
    f32x2 e; e.x = __builtin_amdgcn_exp2f(s.x); e.y = __builtin_amdgcn_exp2f(s.y);
    const f32x2 m = v * (q * e), r = v - m;
    f32x2 o; o.x = v.x < 0.f ? m.x : r.x; o.y = v.y < 0.f ? m.y : r.y; return o;
}
__device__ __forceinline__ f32x4 gelu4(f32x4 v) { const f32x2 a = gelu_pk((f32x2){v[0], v[1]}), b = gelu_pk((f32x2){v[2], v[3]}); return (f32x4){a.x, a.y, b.x, b.y}; }

template <class Epi, class Sched>
__device__ __forceinline__ void gemm_phase(PG8_LAS unsigned char* lds, const Gemm g, const Sched& S, const Epi& E) {
    const int tid = threadIdx.x, wid = __builtin_amdgcn_readfirstlane(tid >> 6), lane = tid & 63, wr = wid >> 2, wc = wid & 3, fr = lane & 15, fq = lane >> 4;
    const int K = g.K, nt = K / BK;
    unsigned voffA[2], voffB[2];
#pragma unroll
    for (int i = 0; i < 2; ++i) { int R, C; stage_rc(tid * 16 + i * 8192, R, C); const int Rb = Epi::PERM ? ((R & ~31) + perm32(R & 31)) : R;
        voffA[i] = (unsigned)(R * g.lda + C) * 2u; voffB[i] = (unsigned)(Rb * g.ldb + C) * 2u; }
    const size_t kstep = (size_t)(BK * 2);
    const size_t hstepA = (size_t)HALF * g.lda * 2, hstepB = (size_t)HALF * g.ldb * 2;
    const size_t tstepA = 2 * hstepA, tstepB = 2 * hstepB;
    const unsigned ldsw = (unsigned)wid * 1024u;
    const int aoff = lds_byte(wr * 64 + fr, fq * 8), boff = lds_byte(wc * 32 + fr, fq * 8);
#define PG8_SA(b, h) (((b) * 2 + (h)) * HTB)
#define PG8_SB(b, h) ((4 + (b) * 2 + (h)) * HTB)
#define PG8_STAGE(bufoff, gbase, voff) do { _Pragma("unroll") for (int _i = 0; _i < 2; ++_i) \
        __builtin_amdgcn_global_load_lds((const unsigned*)((const char*)(gbase) + (voff)[_i]), (PG8_LAS unsigned*)(lds + (bufoff) + ldsw + _i * 8192), 16, 0, 0); } while (0)
#define PG8_LDA(dst, b, h) do { _Pragma("unroll") for (int m = 0; m < 4; ++m) _Pragma("unroll") for (int k = 0; k < 2; ++k) dst[m][k] = *(const PG8_LAS bf16x8*)(lds + PG8_SA(b, h) + aoff + m * 2048 + k * 1024); } while (0)
#define PG8_LDB(dst, b, h) do { _Pragma("unroll") for (int n = 0; n < 2; ++n) _Pragma("unroll") for (int k = 0; k < 2; ++k) dst[n][k] = *(const PG8_LAS bf16x8*)(lds + PG8_SB(b, h) + boff + n * 2048 + k * 1024); } while (0)
#define PG8_MMA(ai, bj, At, Bt) do { __builtin_amdgcn_s_setprio(1); _Pragma("unroll") for (int m = 0; m < 4; ++m) _Pragma("unroll") for (int n = 0; n < 2; ++n) _Pragma("unroll") for (int k = 0; k < 2; ++k) \
        acc[ai][bj][m][n] = __builtin_amdgcn_mfma_f32_16x16x32_bf16(Bt[n][k], At[m][k], acc[ai][bj][m][n], 0, 0, 0); __builtin_amdgcn_s_setprio(0); } while (0)
#define PG8_WAIT_V(n) asm volatile("s_waitcnt vmcnt(" #n ")" ::: "memory")
#define PG8_WAIT_L(n) asm volatile("s_waitcnt lgkmcnt(" #n ")" ::: "memory")
#define PG8_BAR __builtin_amdgcn_s_barrier()
#define PG8_SCHED __builtin_amdgcn_sched_barrier(0)
    Unit cur, nxt; int ui = 0;
    if (!S.next(0, cur)) return;
    f32x4 acc[2][2][4][2];
#pragma unroll
    for (int a = 0; a < 2; ++a)
#pragma unroll
        for (int b = 0; b < 2; ++b)
#pragma unroll
            for (int m = 0; m < 4; ++m)
#pragma unroll
                for (int n = 0; n < 2; ++n) acc[a][b][m][n] = (f32x4){0.f, 0.f, 0.f, 0.f};
    bf16x8 At[4][2], B0[2][2], B1[2][2];
    const char* cA = (const char*)g.A + (size_t)cur.pm * tstepA; const char* cB = (const char*)g.Bt + (size_t)cur.pn * tstepB;
    PG8_STAGE(PG8_SB(0, 0), cB, voffB); PG8_STAGE(PG8_SB(0, 1), cB + hstepB, voffB); PG8_STAGE(PG8_SA(0, 0), cA, voffA); PG8_STAGE(PG8_SA(0, 1), cA + hstepA, voffA);
    if (wr == 1) PG8_BAR;
    PG8_WAIT_V(2); PG8_BAR;
    PG8_STAGE(PG8_SB(1, 0), cB + kstep, voffB); PG8_STAGE(PG8_SA(1, 0), cA + kstep, voffA); PG8_STAGE(PG8_SB(1, 1), cB + hstepB + kstep, voffB);
    PG8_WAIT_V(6); PG8_BAR;
    for (;;) {
        const bool has_next = S.next(ui + 1, nxt);
        const char* nA = has_next ? (const char*)g.A + (size_t)nxt.pm * tstepA : cA; const char* nB = has_next ? (const char*)g.Bt + (size_t)nxt.pn * tstepB : cB;
        for (int t = 0; t < nt; t += 2) {
            const bool last = (t == nt - 2);
            const char* a1 = cA + (size_t)(t + 1) * kstep;
            const char* a2 = last ? nA : cA + (size_t)(t + 2) * kstep; const char* b2 = last ? nB : cB + (size_t)(t + 2) * kstep;
            const char* a3 = a2 + kstep; const char* b3 = b2 + kstep;
            PG8_LDB(B0, 0, 0); PG8_LDB(B1, 0, 1); PG8_SCHED; PG8_LDA(At, 0, 0); PG8_STAGE(PG8_SA(1, 1), a1 + hstepA, voffA);
            PG8_WAIT_V(8); PG8_WAIT_L(0); PG8_BAR; PG8_MMA(0, 0, At, B0); PG8_MMA(0, 1, At, B1); PG8_BAR; PG8_SCHED;
            PG8_LDA(At, 0, 1); PG8_STAGE(PG8_SB(0, 0), b2, voffB); PG8_STAGE(PG8_SB(0, 1), b2 + hstepB, voffB); PG8_STAGE(PG8_SA(0, 0), a2, voffA);
            PG8_WAIT_V(8); PG8_WAIT_L(0); PG8_BAR; PG8_MMA(1, 0, At, B0); PG8_MMA(1, 1, At, B1); PG8_BAR; PG8_SCHED;
            PG8_LDB(B0, 1, 0); PG8_LDB(B1, 1, 1); PG8_SCHED; PG8_LDA(At, 1, 0); PG8_STAGE(PG8_SA(0, 1), a2 + hstepA, voffA);
            PG8_WAIT_V(8); PG8_WAIT_L(0); PG8_BAR; PG8_MMA(0, 0, At, B0); PG8_MMA(0, 1, At, B1); PG8_BAR; PG8_SCHED;
            PG8_LDA(At, 1, 1); PG8_STAGE(PG8_SB(1, 0), b3, voffB); PG8_STAGE(PG8_SB(1, 1), b3 + hstepB, voffB); PG8_STAGE(PG8_SA(1, 0), a3, voffA);
            PG8_WAIT_V(8); PG8_WAIT_L(0); PG8_BAR; PG8_MMA(1, 0, At, B0); PG8_MMA(1, 1, At, B1); PG8_BAR; PG8_SCHED;
        }
        if (wr == 0) PG8_BAR;
        E(acc, cur, wr, wc, fr, fq);
        if (!has_next) break;
#pragma unroll
        for (int a = 0; a < 2; ++a)
#pragma unroll
            for (int b = 0; b < 2; ++b)
#pragma unroll
                for (int m = 0; m < 4; ++m)
#pragma unroll
                    for (int n = 0; n < 2; ++n) acc[a][b][m][n] = (f32x4){0.f, 0.f, 0.f, 0.f};
        cur = nxt; cA = nA; cB = nB; ++ui;
        if (wr == 1) PG8_BAR;
    }
    PG8_WAIT_V(0);
    PG8_BAR;
#undef PG8_SA
#undef PG8_SB
#undef PG8_STAGE
#undef PG8_LDA
#undef PG8_LDB
#undef PG8_MMA
#undef PG8_WAIT_V
#undef PG8_WAIT_L
#undef PG8_BAR
#undef PG8_SCHED
}
}

using pg8::bf16_t; using pg8::bf16x8; using pg8::f32x4; using pg8::f32x2; using pg8::u32x4; using pg8::u32x2; using pg8::cvt_pk_bf16; using pg8::Unit;
#define LAS __attribute__((address_space(3)))

constexpr int DM = 2048, DFF = 5632, DA = 1024, DB = 1024, DKV = 256, DIN = 7680;
constexpr int MP = 32768, MS = 256, MT = MP + MS, SEQ = 8192;
constexpr int MODW = 18432;
constexpr float EPS = 1e-6f;
constexpr int NWAVES = 8, NTHR = 512;
constexpr int LDS_BYTES = 147456;

constexpr size_t O_Y = 0, O_KP = (size_t)MT * DM, O_VP = O_KP + 131072, O_KS = O_VP + 131072, O_VS = O_KS + 262144, O_GV = O_VS + 262144, O_END = O_GV + 262144;

constexpr size_t MiB = 1u << 20;
constexpr size_t WS_MOD = 1 * MiB, WS_ROPE = 2 * MiB, WS_STATS = 3 * MiB;
constexpr size_t WS_W13 = 8 * MiB, WS_W2 = 52 * MiB, WS_WIN = 74 * MiB, WS_WPAB = 104 * MiB, WS_WO = 112 * MiB;
constexpr size_t WS_X1 = 120 * MiB, WS_H = 378 * MiB, WS_G = 507 * MiB;
constexpr size_t SZ_M1024 = (size_t)MT * 1024 * 2, SZ_M256 = (size_t)MT * 256 * 2, SZ_M2048 = (size_t)MT * 2048 * 2;
constexpr size_t WS_U = WS_G, WS_GV = WS_U + SZ_M1024, WS_Q = WS_GV + SZ_M1024, WS_K = WS_Q + SZ_M1024, WS_V = WS_K + SZ_M256, WS_GA = WS_V + SZ_M256, WS_GB = WS_GA + SZ_M2048, WS_END = WS_GB + SZ_M2048;
constexpr size_t WS_Y = WS_U;
constexpr size_t WS_AO = WS_H;
static_assert(WS_G + (size_t)MT * DFF * 2 <= 1024 * MiB && WS_END <= 1024 * MiB, "workspace map");
static_assert(WS_STATS + (size_t)MT * 16 * 8 <= WS_W13, "stats");

struct Args { const float* in[28]; float* out; unsigned char* ws; int ph_lo, ph_hi; };

__device__ __forceinline__ int mrow(int row) { return row < MP ? (row >> 13) : 4 + ((row - MP) >> 5); }
__device__ __forceinline__ float bf_lo(unsigned w) { return __uint_as_float(w << 16); }
__device__ __forceinline__ float bf_hi(unsigned w) { return __uint_as_float(w & 0xffff0000u); }
__device__ __forceinline__ float wave_sum(float v) {
#pragma unroll
    for (int o = 1; o < 64; o <<= 1) v += __shfl_xor(v, o);
    return v;
}
__device__ __forceinline__ float sigmoidf_(float x) { return __builtin_amdgcn_rcpf(1.0f + __expf(-x)); }

struct EpiSwiGLU {
    static constexpr bool PERM = true;
    bf16_t* G;
    __device__ __forceinline__ void operator()(const f32x4 (&acc)[2][2][4][2], const Unit& u, int wr, int wc, int fr, int fq) const {
        const int row0 = u.pm * 256 + wr * 64 + fr, col = u.pn * 128 + wc * 32 + 8 * fq;
#pragma unroll
        for (int ai = 0; ai < 2; ++ai)
#pragma unroll
            for (int m = 0; m < 4; ++m) {
                const int row = row0 + ai * 128 + m * 16;
                f32x4 r[2];
#pragma unroll
                for (int n = 0; n < 2; ++n) { const f32x4 a = acc[ai][0][m][n], b = acc[ai][1][m][n];
#pragma unroll
                    for (int e = 0; e < 4; ++e) r[n][e] = a[e] * b[e] * sigmoidf_(a[e]); }
                u32x4 w; w.x = cvt_pk_bf16(r[0][0], r[0][1]); w.y = cvt_pk_bf16(r[0][2], r[0][3]); w.z = cvt_pk_bf16(r[1][0], r[1][1]); w.w = cvt_pk_bf16(r[1][2], r[1][3]);
                *(u32x4*)(G + (size_t)row * DFF + col) = w;
            }
    }
};

struct EpiResid {
    static constexpr bool PERM = false;
    const float* baseP; const float* baseS; float* out; const float* gate; float coef;
    __device__ __forceinline__ void operator()(const f32x4 (&acc)[2][2][4][2], const Unit& u, int wr, int wc, int fr, int fq) const {
        const int pm = u.pm; const bool uni = pm < 128;
        const int colb = u.pn * 256 + wc * 32 + 4 * fq;
        f32x4 gv[2][2];
#pragma unroll
        for (int bj = 0; bj < 2; ++bj)
#pragma unroll
            for (int n = 0; n < 2; ++n) gv[bj][n] = *(const f32x4*)(gate + (size_t)(uni ? (pm >> 5) : 4) * MODW + colb + bj * 128 + n * 16) * coef;
#pragma unroll
        for (int ai = 0; ai < 2; ++ai)
#pragma unroll
            for (int m = 0; m < 4; ++m) {
                const int row = pm * 256 + ai * 128 + wr * 64 + m * 16 + fr;
                const float* bp = row < MP ? baseP + (size_t)row * DM : baseS + (size_t)(row - MP) * DM;
                const int mr = mrow(row);
#pragma unroll
                for (int bj = 0; bj < 2; ++bj)
#pragma unroll
                    for (int n = 0; n < 2; ++n) { const int col = colb + bj * 128 + n * 16;
                        f32x4 gg = gv[bj][n]; if (!uni) gg = *(const f32x4*)(gate + (size_t)mr * MODW + col) * coef;
                        const f32x4 b = *(const f32x4*)(bp + col);
                        *(f32x4*)(out + (size_t)row * DM + col) = b + gg * acc[ai][bj][m][n]; }
            }
    }
};

struct EpiMerge1 {
    static constexpr bool PERM = false;
    const bf16_t* GA; float* T;
    __device__ __forceinline__ void operator()(const f32x4 (&acc)[2][2][4][2], const Unit& u, int wr, int wc, int fr, int fq) const {
        const int colb = u.pn * 256 + wc * 32 + 4 * fq;
#pragma unroll
        for (int ai = 0; ai < 2; ++ai)
#pragma unroll
            for (int m = 0; m < 4; ++m) {
                const size_t ro = (size_t)(u.pm * 256 + ai * 128 + wr * 64 + m * 16 + fr) * DM;
#pragma unroll
                for (int bj = 0; bj < 2; ++bj)
#pragma unroll
                    for (int n = 0; n < 2; ++n) { const int col = colb + bj * 128 + n * 16;
                        const u32x2 gw = *(const u32x2*)(GA + ro + col);
                        const f32x4 gg = (f32x4){bf_lo(gw.x), bf_hi(gw.x), bf_lo(gw.y), bf_hi(gw.y)};
                        *(f32x4*)(T + ro + col) = gg * acc[ai][bj][m][n]; }
            }
    }
};
struct EpiMerge2 {
    static constexpr bool PERM = false;
    const bf16_t* GB; const float* T; bf16_t* Y;
    __device__ __forceinline__ void operator()(const f32x4 (&acc)[2][2][4][2], const Unit& u, int wr, int wc, int fr, int fq) const {
        const int colb = u.pn * 256 + wc * 32 + 4 * fq;
#pragma unroll
        for (int ai = 0; ai < 2; ++ai)
#pragma unroll
            for (int m = 0; m < 4; ++m) {
                const size_t ro = (size_t)(u.pm * 256 + ai * 128 + wr * 64 + m * 16 + fr) * DM;
#pragma unroll
                for (int bj = 0; bj < 2; ++bj)
#pragma unroll
                    for (int n = 0; n < 2; ++n) { const int col = colb + bj * 128 + n * 16;
                        const u32x2 gw = *(const u32x2*)(GB + ro + col);
                        const f32x4 gg = (f32x4){bf_lo(gw.x), bf_hi(gw.x), bf_lo(gw.y), bf_hi(gw.y)};
                        const f32x4 r = *(const f32x4*)(T + ro + col) + gg * acc[ai][bj][m][n];
                        u32x2 w; w.x = cvt_pk_bf16(r[0], r[1]); w.y = cvt_pk_bf16(r[2], r[3]);
                        *(u32x2*)(Y + ro + col) = w; }
            }
    }
};

struct EpiWin {
    static constexpr bool PERM = true;
    unsigned char* ws; f32x2* stats; const float* gq; const float* gk; const f32x2* rope; float* out;
    __device__ __forceinline__ void operator()(const f32x4 (&acc)[2][2][4][2], const Unit& u, int wr, int wc, int fr, int fq) const {
        const int pn = u.pn, row0 = u.pm * 256 + wr * 64 + fr, cw = wc * 32 + 8 * fq;
        if (pn < 8) {
            bf16_t* dst = (bf16_t*)(ws + WS_U + (pn < 4 ? (size_t)0 : SZ_M1024)) + (pn & 3) * 256 + cw;
#pragma unroll
            for (int ai = 0; ai < 2; ++ai)
#pragma unroll
                for (int m = 0; m < 4; ++m) {
                    const int row = row0 + ai * 128 + m * 16; float s1 = 0.f, s2 = 0.f;
#pragma unroll
                    for (int bj = 0; bj < 2; ++bj) {
                        const f32x4 v0 = pg8::gelu4(acc[ai][bj][m][0]), v1 = pg8::gelu4(acc[ai][bj][m][1]);
                        s1 += (v0[0] + v0[1]) + (v0[2] + v0[3]) + (v1[0] + v1[1]) + (v1[2] + v1[3]);
                        s2 += (v0[0] * v0[0] + v0[1] * v0[1]) + (v0[2] * v0[2] + v0[3] * v0[3]) + (v1[0] * v1[0] + v1[1] * v1[1]) + (v1[2] * v1[2] + v1[3] * v1[3]);
                        u32x4 w; w.x = cvt_pk_bf16(v0[0], v0[1]); w.y = cvt_pk_bf16(v0[2], v0[3]); w.z = cvt_pk_bf16(v1[0], v1[1]); w.w = cvt_pk_bf16(v1[2], v1[3]);
                        *(u32x4*)(dst + (size_t)row * 1024 + bj * 128) = w;
                    }
                    if (pn >= 4) {
                        s1 += __shfl_xor(s1, 16); s1 += __shfl_xor(s1, 32); s2 += __shfl_xor(s2, 16); s2 += __shfl_xor(s2, 32);
                        if (fq == 0) stats[(size_t)row * 16 + (pn - 4) * 4 + wc] = (f32x2){s1, s2};
                    }
                }
        } else if (pn < 14) {
            const int t = pn - 8; const bool isq = t < 4, isk = t == 4, isv = t == 5;
            const float* gvec = isq ? gq : gk;
            f32x4 gg[2][2];
#pragma unroll
            for (int bj = 0; bj < 2; ++bj)
#pragma unroll
                for (int n = 0; n < 2; ++n) gg[bj][n] = *(const f32x4*)(gvec + 32 * bj + 8 * fq + 4 * n);
#pragma unroll
            for (int ai = 0; ai < 2; ++ai)
#pragma unroll
                for (int m = 0; m < 4; ++m) {
                    const int row = row0 + ai * 128 + m * 16;
                    f32x4 x[2][2];
#pragma unroll
                    for (int bj = 0; bj < 2; ++bj)
#pragma unroll
                        for (int n = 0; n < 2; ++n) x[bj][n] = acc[ai][bj][m][n];
                    if (!isv) {
                        float ss = 0.f;
#pragma unroll
                        for (int bj = 0; bj < 2; ++bj)
#pragma unroll
                            for (int n = 0; n < 2; ++n) ss += (x[bj][n][0] * x[bj][n][0] + x[bj][n][1] * x[bj][n][1]) + (x[bj][n][2] * x[bj][n][2] + x[bj][n][3] * x[bj][n][3]);
                        ss += __shfl_xor(ss, 16); ss += __shfl_xor(ss, 32);
                        const float rstd = rsqrtf(ss * (1.0f / 64.0f) + EPS);
#pragma unroll
                        for (int bj = 0; bj < 2; ++bj)
#pragma unroll
                            for (int n = 0; n < 2; ++n) x[bj][n] = x[bj][n] * rstd * gg[bj][n];
                        const int pos = row < MP ? (row & (SEQ - 1)) : 2048 + ((row - MP) & 31);
                        f32x4 pr[2];
#pragma unroll
                        for (int n = 0; n < 2; ++n)
#pragma unroll
                            for (int e = 0; e < 4; ++e) pr[n][e] = __shfl_xor(x[0][n][e], 16);
                        if (fq < 2) {
                            const float sgn = fq == 0 ? -1.0f : 1.0f;
#pragma unroll
                            for (int n = 0; n < 2; ++n) {
                                const f32x4 c01 = *(const f32x4*)(rope + (size_t)pos * 8 + 4 * n), c23 = *(const f32x4*)(rope + (size_t)pos * 8 + 4 * n + 2);
                                x[0][n][0] = x[0][n][0] * c01[0] + sgn * pr[n][0] * c01[1];
                                x[0][n][1] = x[0][n][1] * c01[2] + sgn * pr[n][1] * c01[3];
                                x[0][n][2] = x[0][n][2] * c23[0] + sgn * pr[n][2] * c23[1];
                                x[0][n][3] = x[0][n][3] * c23[2] + sgn * pr[n][3] * c23[3];
                            }
                        }
                    }
                    bf16_t* dst = isq ? (bf16_t*)(ws + WS_Q) + (size_t)row * 1024 + (4 * t + wc) * 64 : (bf16_t*)(ws + WS_K + (isk ? (size_t)0 : SZ_M256)) + (size_t)row * 256 + wc * 64;
#pragma unroll
                    for (int bj = 0; bj < 2; ++bj) {
                        u32x4 w; w.x = cvt_pk_bf16(x[bj][0][0], x[bj][0][1]); w.y = cvt_pk_bf16(x[bj][0][2], x[bj][0][3]); w.z = cvt_pk_bf16(x[bj][1][0], x[bj][1][1]); w.w = cvt_pk_bf16(x[bj][1][2], x[bj][1][3]);
                        *(u32x4*)(dst + 32 * bj + 8 * fq) = w;
                    }
                    if (!isq) {
                        float* o = nullptr;
                        if (row < MP) { const int tp = row & (SEQ - 1); if (tp >= SEQ - 128) o = out + (isk ? O_KP : O_VP) + ((size_t)((row >> 13) * 128 + tp - (SEQ - 128)) * 4 + wc) * 64; }
                        else { const int j = (row - MP) & 31, b = (row - MP) >> 5; o = out + (isk ? O_KS : O_VS) + ((size_t)(b * 128 + 96 + j) * 4 + wc) * 64; }
                        if (o) {
#pragma unroll
                            for (int bj = 0; bj < 2; ++bj)
#pragma unroll
                                for (int n = 0; n < 2; ++n) *(f32x4*)(o + 32 * bj + 8 * fq + 4 * n) = x[bj][n];
                        }
                    }
                }
        } else {
            bf16_t* dst = (bf16_t*)(ws + WS_GA + (pn < 22 ? (size_t)0 : SZ_M2048)) + ((pn - 14) & 7) * 256 + cw;
#pragma unroll
            for (int ai = 0; ai < 2; ++ai)
#pragma unroll
                for (int m = 0; m < 4; ++m) {
                    const int row = row0 + ai * 128 + m * 16;
#pragma unroll
                    for (int bj = 0; bj < 2; ++bj) {
                        f32x4 v0 = acc[ai][bj][m][0], v1 = acc[ai][bj][m][1];
#pragma unroll
                        for (int e = 0; e < 4; ++e) { v0[e] = sigmoidf_(v0[e]); v1[e] = sigmoidf_(v1[e]); }
                        u32x4 w; w.x = cvt_pk_bf16(v0[0], v0[1]); w.y = cvt_pk_bf16(v0[2], v0[3]); w.z = cvt_pk_bf16(v1[0], v1[1]); w.w = cvt_pk_bf16(v1[2], v1[3]);
                        *(u32x4*)(dst + (size_t)row * 2048 + bj * 128) = w;
                    }
                }
        }
    }
};

__device__ __forceinline__ void transpose_item(const float* W, int N, int k0, int n0, bf16_t* dst  , int ld, LAS float* scr, int lane) {
#pragma unroll 8
    for (int i = 0; i < 32; ++i) { const int kk = 2 * i + (lane >> 5); scr[kk * 33 + (lane & 31)] = W[(size_t)(k0 + kk) * N + n0 + (lane & 31)]; }
    asm volatile("s_waitcnt lgkmcnt(0)" ::: "memory");
    const int c = lane & 7;
#pragma unroll
    for (int j = 0; j < 4; ++j) { const int n = (lane >> 3) + 8 * j; const LAS float* s = scr + (8 * c) * 33 + n;
        u32x4 o; o.x = cvt_pk_bf16(s[0 * 33], s[1 * 33]); o.y = cvt_pk_bf16(s[2 * 33], s[3 * 33]); o.z = cvt_pk_bf16(s[4 * 33], s[5 * 33]); o.w = cvt_pk_bf16(s[6 * 33], s[7 * 33]);
        *(u32x4*)(dst + (size_t)n * ld + 8 * c) = o; }
    asm volatile("s_waitcnt lgkmcnt(0)" ::: "memory");
}
__device__ __forceinline__ void tr_mat(int r, const float* W, int K, int N, bf16_t* dst, int ld, int coff, int kind, LAS float* scr, int lane) {
    const int nblk = N / 32, kb = r / nblk, nb = r - kb * nblk, k0 = 64 * kb, n0 = 32 * nb;
    int drow = n0;
    if (kind == 1) drow = 256 * (n0 >> 7) + (n0 & 127);
    else if (kind == 2) drow = 256 * (n0 >> 7) + 128 + (n0 & 127);
    else if (kind == 3) { if (n0 >= 2048 && n0 < 3584) { const int t = n0 - 2048, tile = t >> 8, o = t & 255; drow = 2048 + 256 * tile + 128 * ((o >> 5) & 1) + 32 * (o >> 6); } }
    transpose_item(W, N, k0, n0, dst + (size_t)drow * ld + coff + k0, ld, scr, lane);
}
constexpr int IT_FFN13 = (DM / 64) * (DFF / 32), IT_FFN2 = (DFF / 64) * (DM / 32), IT_WIN = (DM / 64) * (DIN / 32), IT_WP = (DA / 64) * (DM / 32), IT_WO = (DM / 64) * (DM / 32);
__device__ __forceinline__ void transpose_ffn(const float* w1, const float* w3, const float* w2, unsigned char* ws, LAS float* scr, int gw, int NGW, int lane) {
    for (int it = gw; it < 2 * IT_FFN13 + IT_FFN2; it += NGW) {
        int r = it;
        if (r < IT_FFN13) { tr_mat(r, w1, DM, DFF, (bf16_t*)(ws + WS_W13), DM, 0, 1, scr, lane); continue; } r -= IT_FFN13;
        if (r < IT_FFN13) { tr_mat(r, w3, DM, DFF, (bf16_t*)(ws + WS_W13), DM, 0, 2, scr, lane); continue; } r -= IT_FFN13;
        tr_mat(r, w2, DFF, DM, (bf16_t*)(ws + WS_W2), DFF, 0, 0, scr, lane);
    }
}

__device__ __forceinline__ void norm_phase(const float* srcP, const float* srcS, const float* g, const float* mod, int sub, bf16_t* H, int gw, int NGW, int lane) {
    const int R = (MT + NGW - 1) / NGW, r0 = gw * R, r1 = (r0 + R < MT) ? r0 + R : MT;
    if (r0 >= r1) return;
    int cur = -1; f32x4 gs[8], sh[8], v[8], nv[8];
    { const f32x4* xr = (const f32x4*)(r0 < MP ? srcP + (size_t)r0 * DM : srcS + (size_t)(r0 - MP) * DM) + lane;
#pragma unroll
      for (int j = 0; j < 8; ++j) v[j] = xr[64 * j]; }
    for (int r = r0; r < r1; ++r) {
        if (r + 1 < r1) { const int rn = r + 1; const f32x4* xr = (const f32x4*)(rn < MP ? srcP + (size_t)rn * DM : srcS + (size_t)(rn - MP) * DM) + lane;
#pragma unroll
            for (int j = 0; j < 8; ++j) nv[j] = xr[64 * j]; }
        const int mr = mrow(r);
        if (mr != cur) { cur = mr; const f32x4* g4 = (const f32x4*)g + lane; const f32x4* m4 = (const f32x4*)(mod + (size_t)mr * MODW + sub * 3 * DM) + lane;
#pragma unroll
            for (int j = 0; j < 8; ++j) { gs[j] = g4[64 * j] * (m4[512 + 64 * j] + 1.0f); sh[j] = m4[64 * j]; } }
        float ss = 0.f;
#pragma unroll
        for (int j = 0; j < 8; ++j) ss += (v[j][0] * v[j][0] + v[j][1] * v[j][1]) + (v[j][2] * v[j][2] + v[j][3] * v[j][3]);
        const float rstd = rsqrtf(wave_sum(ss) * (1.0f / DM) + EPS);
        u32x2* o = (u32x2*)(H + (size_t)r * DM) + lane;
#pragma unroll
        for (int j = 0; j < 8; ++j) { const f32x4 h = v[j] * rstd * gs[j] + sh[j]; u32x2 w; w.x = cvt_pk_bf16(h[0], h[1]); w.y = cvt_pk_bf16(h[2], h[3]); o[64 * j] = w; }
#pragma unroll
        for (int j = 0; j < 8; ++j) v[j] = nv[j];
    }
}

constexpr int VNT_LD = 136;
constexpr int KS_LD = 72;
constexpr int VT_LD = 200;
constexpr int VT_OFF = 192 * KS_LD * 2;

__device__ __forceinline__ void spatial_unit(LAS unsigned char* lds, const Args& a, int row0, int nrows, int g, int sb) {
    const int tid = threadIdx.x, w = __builtin_amdgcn_readfirstlane(tid >> 6), lane = tid & 63;
    unsigned char* ws = a.ws;
    const bf16_t* GV = (const bf16_t*)(ws + WS_GV); const bf16_t* U = (const bf16_t*)(ws + WS_U); bf16_t* AO = (bf16_t*)(ws + WS_AO);
    const f32x2* stats = (const f32x2*)(ws + WS_STATS);
    const float* lng = a.in[16]; const float* lnb = a.in[17]; const float* w_s = a.in[18]; const float* b_s = a.in[19];
    LAS bf16_t* vnT = (LAS bf16_t*)lds;
    __syncthreads();
    {
        const int j = tid >> 2, cq = tid & 3;
        if (j < nrows) {
            const int row = row0 + j;
            const f32x4* st = (const f32x4*)(stats + (size_t)row * 16);
            float s1 = 0.f, s2 = 0.f;
#pragma unroll
            for (int i = 0; i < 8; ++i) { const f32x4 p = st[i]; s1 += p[0] + p[2]; s2 += p[1] + p[3]; }
            const float mean = s1 * (1.0f / 1024.0f), var = s2 * (1.0f / 1024.0f) - mean * mean, rstd = rsqrtf(var + EPS);
            const u32x4* src = (const u32x4*)(GV + (size_t)row * 1024 + 128 * g + 32 * cq);
#pragma unroll
            for (int q = 0; q < 4; ++q) {
                const u32x4 pk = src[q]; const int c0 = 32 * cq + 8 * q;
                const f32x4 ga = *(const f32x4*)(lng + 128 * g + c0), gb = *(const f32x4*)(lng + 128 * g + c0 + 4), ba = *(const f32x4*)(lnb + 128 * g + c0), bb = *(const f32x4*)(lnb + 128 * g + c0 + 4);
                f32x4 x0 = (f32x4){bf_lo(pk.x), bf_hi(pk.x), bf_lo(pk.y), bf_hi(pk.y)}, x1 = (f32x4){bf_lo(pk.z), bf_hi(pk.z), bf_lo(pk.w), bf_hi(pk.w)};
                x0 = (x0 - mean) * rstd * ga + ba; x1 = (x1 - mean) * rstd * gb + bb;
                if (sb >= 0) { float* o = a.out + O_GV + (size_t)(sb * 32 + j) * 1024 + 128 * g + c0; *(f32x4*)o = x0; *(f32x4*)(o + 4) = x1; }
                const unsigned p0 = cvt_pk_bf16(x0[0], x0[1]), p1 = cvt_pk_bf16(x0[2], x0[3]), p2 = cvt_pk_bf16(x1[0], x1[1]), p3 = cvt_pk_bf16(x1[2], x1[3]);
                vnT[(c0 + 0) * VNT_LD + j] = (bf16_t)(p0 & 0xffff); vnT[(c0 + 1) * VNT_LD + j] = (bf16_t)(p0 >> 16);
                vnT[(c0 + 2) * VNT_LD + j] = (bf16_t)(p1 & 0xffff); vnT[(c0 + 3) * VNT_LD + j] = (bf16_t)(p1 >> 16);
                vnT[(c0 + 4) * VNT_LD + j] = (bf16_t)(p2 & 0xffff); vnT[(c0 + 5) * VNT_LD + j] = (bf16_t)(p2 >> 16);
                vnT[(c0 + 6) * VNT_LD + j] = (bf16_t)(p3 & 0xffff); vnT[(c0 + 7) * VNT_LD + j] = (bf16_t)(p3 >> 16);
            }
        } else {
#pragma unroll 8
            for (int c = 0; c < 32; ++c) vnT[(32 * cq + c) * VNT_LD + j] = (bf16_t)0;
        }
    }
    const int il = lane & 15, kg = lane >> 4, i = 16 * w + il;
    const int nks = (sb >= 0) ? 1 : (w < 4 ? 2 : 4);
    bf16x8 Bf[4];
#pragma unroll
    for (int ks = 0; ks < 4; ++ks) {
        if (ks < nks) { const float* wp = w_s + (size_t)g * 16384 + i * 128 + 32 * ks + 8 * kg; const f32x4 a0 = *(const f32x4*)wp, a1 = *(const f32x4*)(wp + 4);
            u32x4 pk; pk.x = cvt_pk_bf16(a0[0], a0[1]); pk.y = cvt_pk_bf16(a0[2], a0[3]); pk.z = cvt_pk_bf16(a1[0], a1[1]); pk.w = cvt_pk_bf16(a1[2], a1[3]);
            Bf[ks] = __builtin_bit_cast(bf16x8, pk); }
        else Bf[ks] = (bf16x8){0, 0, 0, 0, 0, 0, 0, 0};
    }
    __syncthreads();
    if (sb >= 0 && w >= 2) return;
    f32x4 acc[8];
#pragma unroll
    for (int cb = 0; cb < 8; ++cb) {
        acc[cb] = (f32x4){0.f, 0.f, 0.f, 0.f};
#pragma unroll
        for (int ks = 0; ks < 4; ++ks)
            if (ks < nks) { const bf16x8 Af = *(const LAS bf16x8*)(vnT + (16 * cb + il) * VNT_LD + 32 * ks + 8 * kg);
                acc[cb] = __builtin_amdgcn_mfma_f32_16x16x32_bf16(Af, Bf[ks], acc[cb], 0, 0, 0); }
    }
    if (i < nrows) {
        const float bs = b_s[g * 128 + i]; const size_t row = (size_t)(row0 + i);
#pragma unroll
        for (int cb = 0; cb < 8; ++cb) {
            const int c = 128 * g + 16 * cb + 4 * kg;
            const u32x2 uw = *(const u32x2*)(U + row * 1024 + c);
            const f32x4 uu = (f32x4){bf_lo(uw.x), bf_hi(uw.x), bf_lo(uw.y), bf_hi(uw.y)};
            const f32x4 r = uu * (acc[cb] + bs);
            u32x2 o; o.x = cvt_pk_bf16(r[0], r[1]); o.y = cvt_pk_bf16(r[2], r[3]);
            *(u32x2*)(AO + row * 2048 + c) = o;
        }
    }
}

__device__ __forceinline__ void attn_unit(LAS unsigned char* lds, const Args& a, int b, int cn, int kvh, int sb) {
    const int tid = threadIdx.x, w = __builtin_amdgcn_readfirstlane(tid >> 6), lane = tid & 63, il = lane & 15, kg = lane >> 4;
    unsigned char* ws = a.ws;
    const bf16_t* Q = (const bf16_t*)(ws + WS_Q); const bf16_t* Kb = (const bf16_t*)(ws + WS_K); const bf16_t* Vb = (const bf16_t*)(ws + WS_V); bf16_t* AO = (bf16_t*)(ws + WS_AO);
    LAS bf16_t* Ks = (LAS bf16_t*)lds; LAS bf16_t* VT = (LAS bf16_t*)(lds + VT_OFF);
    const bool samp = sb >= 0;
    __syncthreads();
#pragma unroll
    for (int p = 0; p < 3; ++p) {
        const int idx = p * NTHR + tid, key = idx >> 3, part = idx & 7;
        u32x4 k8 = (u32x4){0u, 0u, 0u, 0u}, v8 = (u32x4){0u, 0u, 0u, 0u};
        if (!samp) {
            const int pos = 64 * (cn - 2) + key;
            if (pos >= 0) { const size_t off = (size_t)(b * SEQ + pos) * 256 + kvh * 64 + part * 8; k8 = *(const u32x4*)(Kb + off); v8 = *(const u32x4*)(Vb + off); }
        } else if (key < 128) {
            const size_t off = ((size_t)(sb * 128 + key) * 4 + kvh) * 64 + part * 8;
            const f32x4 k0 = *(const f32x4*)(a.in[2] + off), k1 = *(const f32x4*)(a.in[2] + off + 4), v0 = *(const f32x4*)(a.in[3] + off), v1 = *(const f32x4*)(a.in[3] + off + 4);
            k8.x = cvt_pk_bf16(k0[0], k0[1]); k8.y = cvt_pk_bf16(k0[2], k0[3]); k8.z = cvt_pk_bf16(k1[0], k1[1]); k8.w = cvt_pk_bf16(k1[2], k1[3]);
            v8.x = cvt_pk_bf16(v0[0], v0[1]); v8.y = cvt_pk_bf16(v0[2], v0[3]); v8.z = cvt_pk_bf16(v1[0], v1[1]); v8.w = cvt_pk_bf16(v1[2], v1[3]);
        } else if (key < 160) {
            const size_t off = (size_t)(MP + sb * 32 + key - 128) * 256 + kvh * 64 + part * 8; k8 = *(const u32x4*)(Kb + off); v8 = *(const u32x4*)(Vb + off);
        }
        *(LAS u32x4*)(Ks + key * KS_LD + part * 8) = k8;
        LAS bf16_t* vt = VT + (part * 8) * VT_LD + key;
        vt[0 * VT_LD] = (bf16_t)(v8.x & 0xffff); vt[1 * VT_LD] = (bf16_t)(v8.x >> 16); vt[2 * VT_LD] = (bf16_t)(v8.y & 0xffff); vt[3 * VT_LD] = (bf16_t)(v8.y >> 16);
        vt[4 * VT_LD] = (bf16_t)(v8.z & 0xffff); vt[5 * VT_LD] = (bf16_t)(v8.z >> 16); vt[6 * VT_LD] = (bf16_t)(v8.w & 0xffff); vt[7 * VT_LD] = (bf16_t)(v8.w >> 16);
    }
    const int hq = 4 * kvh + (w >> 1);
    const int qrow0 = samp ? MP + sb * 32 + (w & 1) * 16 : b * SEQ + 64 * cn + (w & 1) * 32;
    const int kb_lo = samp ? 0 : (cn < 2 ? 4 * (2 - cn) : 0), kb_hi = samp ? 10 : 12;
    bf16x8 Qf[2][2];
#pragma unroll
    for (int qb = 0; qb < 2; ++qb) { const int row = qrow0 + ((samp && qb) ? 0 : 16 * qb) + il;
#pragma unroll
        for (int ks = 0; ks < 2; ++ks) Qf[qb][ks] = *(const bf16x8*)(Q + (size_t)row * 1024 + hq * 64 + 32 * ks + 8 * kg); }
    __syncthreads();
    f32x4 S[2][12];
#pragma unroll
    for (int kb = 0; kb < 12; ++kb) {
#pragma unroll
        for (int qb = 0; qb < 2; ++qb) S[qb][kb] = (f32x4){0.f, 0.f, 0.f, 0.f};
        if (kb >= kb_lo && kb < kb_hi) {
#pragma unroll
            for (int ks = 0; ks < 2; ++ks) { const bf16x8 Kf = *(const LAS bf16x8*)(Ks + (16 * kb + il) * KS_LD + 32 * ks + 8 * kg);
#pragma unroll
                for (int qb = 0; qb < 2; ++qb) S[qb][kb] = __builtin_amdgcn_mfma_f32_16x16x32_bf16(Kf, Qf[qb][ks], S[qb][kb], 0, 0, 0); }
        }
    }
    const float sink = a.in[20][hq];
    float linv[2];
#pragma unroll
    for (int qb = 0; qb < 2; ++qb) {
        float mx = sink;
#pragma unroll
        for (int kb = 0; kb < 12; ++kb) if (kb >= kb_lo && kb < kb_hi) {
#pragma unroll
            for (int e = 0; e < 4; ++e) { S[qb][kb][e] *= 0.125f; mx = fmaxf(mx, S[qb][kb][e]); } }
        mx = fmaxf(mx, __shfl_xor(mx, 16)); mx = fmaxf(mx, __shfl_xor(mx, 32));
        float l = 0.f;
#pragma unroll
        for (int kb = 0; kb < 12; ++kb) {
            if (kb >= kb_lo && kb < kb_hi) {
#pragma unroll
                for (int e = 0; e < 4; ++e) { const float p = __expf(S[qb][kb][e] - mx); S[qb][kb][e] = p; l += p; }
            } else S[qb][kb] = (f32x4){0.f, 0.f, 0.f, 0.f};
        }
        l += __shfl_xor(l, 16); l += __shfl_xor(l, 32);
        l += __expf(sink - mx);
        linv[qb] = 1.0f / l;
    }
    f32x4 O[2][4];
#pragma unroll
    for (int qb = 0; qb < 2; ++qb)
#pragma unroll
        for (int db = 0; db < 4; ++db) O[qb][db] = (f32x4){0.f, 0.f, 0.f, 0.f};
#pragma unroll
    for (int t = 0; t < 6; ++t) {
        if (2 * t + 1 >= kb_lo && 2 * t < kb_hi) {
            bf16x8 Pf[2];
#pragma unroll
            for (int qb = 0; qb < 2; ++qb) { u32x4 pk; pk.x = cvt_pk_bf16(S[qb][2 * t][0], S[qb][2 * t][1]); pk.y = cvt_pk_bf16(S[qb][2 * t][2], S[qb][2 * t][3]);
                pk.z = cvt_pk_bf16(S[qb][2 * t + 1][0], S[qb][2 * t + 1][1]); pk.w = cvt_pk_bf16(S[qb][2 * t + 1][2], S[qb][2 * t + 1][3]); Pf[qb] = __builtin_bit_cast(bf16x8, pk); }
#pragma unroll
            for (int db = 0; db < 4; ++db) {
                const LAS bf16_t* vp = VT + (16 * db + il) * VT_LD + 32 * t + 4 * kg;
                const u32x2 lo = *(const LAS u32x2*)vp, hi = *(const LAS u32x2*)(vp + 16);
                const bf16x8 Vf = __builtin_bit_cast(bf16x8, (u32x4){lo.x, lo.y, hi.x, hi.y});
#pragma unroll
                for (int qb = 0; qb < 2; ++qb) O[qb][db] = __builtin_amdgcn_mfma_f32_16x16x32_bf16(Vf, Pf[qb], O[qb][db], 0, 0, 0);
            }
        }
    }
#pragma unroll
    for (int qb = 0; qb < 2; ++qb) {
        if (samp && qb) continue;
        const size_t row = (size_t)(qrow0 + 16 * qb + il);
#pragma unroll
        for (int db = 0; db < 4; ++db) { const f32x4 r = O[qb][db] * linv[qb]; u32x2 o; o.x = cvt_pk_bf16(r[0], r[1]); o.y = cvt_pk_bf16(r[2], r[3]);
            *(u32x2*)(AO + row * 2048 + 1024 + hq * 64 + 16 * db + 4 * kg) = o; }
    }
}

__global__ void __launch_bounds__(NTHR, 2) fwd_kernel(Args a) {
    extern __shared__ __attribute__((aligned(16))) unsigned char lds_raw[];
    LAS unsigned char* lds = (LAS unsigned char*)lds_raw;
    const int tid = threadIdx.x, lane = tid & 63, wave = __builtin_amdgcn_readfirstlane(tid >> 6);
    const int G = gridDim.x, bx = blockIdx.x;
    const int gw = bx * NWAVES + wave, NGW = G * NWAVES;
    unsigned char* ws = a.ws; float* out = a.out;
    float* MOD = (float*)(ws + WS_MOD); f32x2* ROPE = (f32x2*)(ws + WS_ROPE); f32x2* STATS = (f32x2*)(ws + WS_STATS);
    bf16_t* W13 = (bf16_t*)(ws + WS_W13); bf16_t* W2 = (bf16_t*)(ws + WS_W2); bf16_t* WIN = (bf16_t*)(ws + WS_WIN); bf16_t* WPAB = (bf16_t*)(ws + WS_WPAB); bf16_t* WO = (bf16_t*)(ws + WS_WO);
    float* X1 = (float*)(ws + WS_X1); bf16_t* H = (bf16_t*)(ws + WS_H); bf16_t* Gb = (bf16_t*)(ws + WS_G);
    const int lo = a.ph_lo, hi = a.ph_hi;
#define IN(k) (lo <= (k) && (k) < hi)
#define SEAM(k) do { if (IN(k) && IN((k) + 1)) cg::this_grid().sync(); } while (0)

    if (IN(0)) {
        {
            const float invf[8] = {1.0f, 0.1939227432012558f, 0.03760603070259094f, 0.007292664609849453f, 0.0014142135623842478f, 0.00027424818836152554f, 5.318296098266728e-05f, 1.0313386155758053e-05f};
            for (int i = bx * NTHR + tid; i < SEQ * 8; i += G * NTHR) {
                const int pos = i >> 3, f = i & 7;
                float fv = invf[0];
#pragma unroll
                for (int q = 1; q < 8; ++q) fv = (f == q) ? invf[q] : fv;
                const float ang = (float)pos * fv;
                const double ad = (double)ang; const double n = __builtin_rint(ad * 0.15915494309189535); const float rr = (float)(ad - n * 6.283185307179586);
                ROPE[i] = (f32x2){cosf(rr), sinf(rr)};
            }
            for (int i = bx * NTHR + tid; i < 8 * 24576 / 4; i += G * NTHR) {
                const int b = i / 6144, o = (i - b * 6144) * 4;
                *(f32x4*)(out + O_KS + (size_t)b * 32768 + o) = *(const f32x4*)(a.in[2] + (size_t)b * 32768 + 8192 + o);
                *(f32x4*)(out + O_VS + (size_t)b * 32768 + o) = *(const f32x4*)(a.in[3] + (size_t)b * 32768 + 8192 + o);
            }
        }
        {
            LAS float* sl = (LAS float*)lds;
            LAS float* red = (LAS float*)(lds + 98304);
            for (int idx = tid; idx < 12 * 2048; idx += NTHR) { const int r = idx >> 11, k = idx & 2047; const float c = r < 4 ? a.in[4][r * 2048 + k] : a.in[5][(r - 4) * 2048 + k]; sl[k * 12 + r] = c * sigmoidf_(c); }
            __syncthreads();
            for (int cb = bx; cb < MODW / 64; cb += G) {
                float acc[12];
#pragma unroll
                for (int r = 0; r < 12; ++r) acc[r] = 0.f;
                const float* wp = a.in[6] + (size_t)(wave * 256) * MODW + cb * 64 + lane;
#pragma unroll 8
                for (int k = 0; k < 256; ++k) {
                    const float wv = wp[(size_t)k * MODW];
                    const LAS f32x4* sp = (const LAS f32x4*)(sl + (wave * 256 + k) * 12);
                    const f32x4 s0 = sp[0], s1 = sp[1], s2 = sp[2];
                    acc[0] += s0[0] * wv; acc[1] += s0[1] * wv; acc[2] += s0[2] * wv; acc[3] += s0[3] * wv;
                    acc[4] += s1[0] * wv; acc[5] += s1[1] * wv; acc[6] += s1[2] * wv; acc[7] += s1[3] * wv;
                    acc[8] += s2[0] * wv; acc[9] += s2[1] * wv; acc[10] += s2[2] * wv; acc[11] += s2[3] * wv;
                }
#pragma unroll
                for (int r = 0; r < 12; ++r) red[(wave * 12 + r) * 64 + lane] = acc[r];
                __syncthreads();
                for (int o = tid; o < 768; o += NTHR) { const int r = o >> 6, cl = o & 63; float s = a.in[7][cb * 64 + cl];
#pragma unroll
                    for (int q = 0; q < 8; ++q) s += red[(q * 12 + r) * 64 + cl];
                    MOD[(size_t)r * MODW + cb * 64 + cl] = s; }
                __syncthreads();
            }
        }
        __syncthreads();
        {
            LAS float* scr = (LAS float*)(lds + wave * 8448);
            transpose_ffn(a.in[9], a.in[10], a.in[11], ws, scr, gw, NGW, lane);
            for (int it = gw; it < IT_WIN + 2 * IT_WP + IT_WO; it += NGW) {
                int r = it;
                if (r < IT_WIN) { tr_mat(r, a.in[13], DM, DIN, WIN, DM, 0, 3, scr, lane); continue; } r -= IT_WIN;
                if (r < IT_WP) { tr_mat(r, a.in[21], DA, DM, WPAB, 2048, 0, 0, scr, lane); continue; } r -= IT_WP;
                if (r < IT_WP) { tr_mat(r, a.in[22], DB, DM, WPAB, 2048, 1024, 0, scr, lane); continue; } r -= IT_WP;
                tr_mat(r, a.in[23], DM, DM, WO, DM, 0, 0, scr, lane);
            }
        }
    }
    SEAM(0);
    if (IN(1)) norm_phase(a.in[0], a.in[1], a.in[8], MOD, 0, H, gw, NGW, lane);
    SEAM(1);
    if (IN(2)) { pg8::Gemm g{H, W13, MT, 2 * DFF, DM, DM, DM}; pg8::StaticOrder S; S.init(MT, 2 * DFF, G, bx); EpiSwiGLU E{Gb}; pg8::gemm_phase(lds, g, S, E); }
    SEAM(2);
    if (IN(3)) { pg8::Gemm g{Gb, W2, MT, DM, DFF, DFF, DFF}; pg8::StaticOrder S; S.init(MT, DM, G, bx); EpiResid E{a.in[0], a.in[1], X1, MOD + 0 * 3 * DM + 2 * DM, 0.5f}; pg8::gemm_phase(lds, g, S, E); }
    SEAM(3);
    if (IN(4)) {
        norm_phase(X1, X1 + (size_t)MP * DM, a.in[12], MOD, 1, H, gw, NGW, lane);
        transpose_ffn(a.in[25], a.in[26], a.in[27], ws, (LAS float*)(lds + wave * 8448), gw, NGW, lane);
    }
    SEAM(4);
    if (IN(5)) { pg8::Gemm g{H, WIN, MT, DIN, DM, DM, DM}; pg8::StaticOrder S; S.init(MT, DIN, G, bx);
        EpiWin E{ws, STATS, a.in[14], a.in[15], ROPE, out};
        pg8::gemm_phase(lds, g, S, E); }
    SEAM(5);
    if (IN(6)) {
        for (int it = bx; it < 4192; it += G) {
            if (it < 2048) attn_unit(lds, a, it >> 9, (it >> 2) & 127, it & 3, -1);
            else if (it < 4096) spatial_unit(lds, a, ((it - 2048) >> 3) * 128, 128, it & 7, -1);
            else if (it < 4128) attn_unit(lds, a, 0, 0, it & 3, (it - 4096) >> 2);
            else spatial_unit(lds, a, MP + ((it - 4128) >> 3) * 32, 32, it & 7, (it - 4128) >> 3);
        }
        __syncthreads();
    }
    SEAM(6);
    if (IN(7)) {
        bf16_t* AO = (bf16_t*)(ws + WS_AO); bf16_t* Y = (bf16_t*)(ws + WS_Y); float* T = out + O_Y;
        { pg8::Gemm g{AO, WPAB, MT, DM, DA, 2048, 2048}; pg8::StaticOrder S; S.init(MT, DM, G, bx); EpiMerge1 E{(const bf16_t*)(ws + WS_GA), T}; pg8::gemm_phase(lds, g, S, E); }
        { pg8::Gemm g{AO + 1024, WPAB + 1024, MT, DM, DB, 2048, 2048}; pg8::StaticOrder S; S.init(MT, DM, G, bx); EpiMerge2 E{(const bf16_t*)(ws + WS_GB), T, Y}; pg8::gemm_phase(lds, g, S, E); }
    }
    SEAM(7);
    if (IN(8)) { pg8::Gemm g{(bf16_t*)(ws + WS_Y), WO, MT, DM, DM, DM, DM}; pg8::StaticOrder S; S.init(MT, DM, G, bx); EpiResid E{X1, X1 + (size_t)MP * DM, out + O_Y, MOD + 1 * 3 * DM + 2 * DM, 1.0f}; pg8::gemm_phase(lds, g, S, E); }
    SEAM(8);
    if (IN(9)) norm_phase(out + O_Y, out + O_Y + (size_t)MP * DM, a.in[24], MOD, 2, H, gw, NGW, lane);
    SEAM(9);
    if (IN(10)) { pg8::Gemm g{H, W13, MT, 2 * DFF, DM, DM, DM}; pg8::StaticOrder S; S.init(MT, 2 * DFF, G, bx); EpiSwiGLU E{Gb}; pg8::gemm_phase(lds, g, S, E); }
    SEAM(10);
    if (IN(11)) { pg8::Gemm g{Gb, W2, MT, DM, DFF, DFF, DFF}; pg8::StaticOrder S; S.init(MT, DM, G, bx); EpiResid E{out + O_Y, out + O_Y + (size_t)MP * DM, out + O_Y, MOD + 2 * 3 * DM + 2 * DM, 0.5f}; pg8::gemm_phase(lds, g, S, E); }
#undef IN
#undef SEAM
}

extern "C" void kernel_launch(void* const* d_in, const int* in_sizes, int n_in, void* d_out, int out_size, void* d_ws, size_t ws_size, hipStream_t stream) {
    static int grid = 0;
    if (grid == 0) {
        if (n_in != 28 || (size_t)out_size != O_END || ws_size < 1024 * MiB) { fprintf(stderr, "kernel_launch: unexpected shapes: n_in %d out %d ws %zu\n", n_in, out_size, ws_size); grid = -1; return; }
        int dev = 0, cus = 0, per_cu = 0;
        if (hipGetDevice(&dev) != hipSuccess || hipDeviceGetAttribute(&cus, hipDeviceAttributeMultiprocessorCount, dev) != hipSuccess) { grid = -1; return; }
        if (hipFuncSetAttribute((const void*)fwd_kernel, hipFuncAttributeMaxDynamicSharedMemorySize, LDS_BYTES) != hipSuccess) { fprintf(stderr, "kernel_launch: hipFuncSetAttribute failed\n"); grid = -1; return; }
        if (hipOccupancyMaxActiveBlocksPerMultiprocessor(&per_cu, (const void*)fwd_kernel, NTHR, LDS_BYTES) != hipSuccess || per_cu < 1) { fprintf(stderr, "kernel_launch: occupancy query says %d\n", per_cu); per_cu = 1; }
        (void)hipGetLastError();
        grid = cus * 1;
        fprintf(stderr, "kernel_launch: grid %d (cus %d, per_cu %d)\n", grid, cus, per_cu);
    }
    if (grid < 0) return;
    Args a{};
    for (int i = 0; i < 28; ++i) a.in[i] = (const float*)d_in[i];
    a.out = (float*)d_out; a.ws = (unsigned char*)d_ws;
#if MK_N_LAUNCHES == 1
    a.ph_lo = 0; a.ph_hi = 12;
    void* args[] = {&a};
    hipError_t e = hipLaunchCooperativeKernel((const void*)fwd_kernel, dim3(grid), dim3(NTHR), args, LDS_BYTES, stream);
    if (e != hipSuccess) fprintf(stderr, "kernel_launch: cooperative launch failed: %s (grid %d)\n", hipGetErrorString(e), grid);
#else
    for (int p = 0; p < 12; ++p) { a.ph_lo = p; a.ph_hi = p + 1; hipLaunchKernelGGL(fwd_kernel, dim3(grid), dim3(NTHR), LDS_BYTES, stream, a); }
#endif
}
```

```cpp
#include <hip/hip_runtime.h>
#include <hip/hip_cooperative_groups.h>
#include <cstdio>
#include <cstdint>
namespace cg = cooperative_groups;

#ifndef MK_N_LAUNCHES
#define MK_N_LAUNCHES 1
#endif

namespace pg8 {
#define PG8_LAS __attribute__((address_space(3)))
typedef unsigned short bf16_t;
typedef short bf16x8 __attribute__((ext_vector_type(8)));
typedef float f32x4 __attribute__((ext_vector_type(4)));
typedef float f32x2 __attribute__((ext_vector_type(2)));
typedef unsigned u32x4 __attribute__((ext_vector_type(4)));
typedef unsigned u32x2 __attribute__((ext_vector_type(2)));
constexpr int BM = 256, BK = 64, HALF = 128, HTB = HALF * BK * 2, STAGE_BYTES = 8 * HTB, NXCD = 8, WGM = 8;

__host__ __device__ __forceinline__ int lds_byte(int r, int c) { const int st = (r >> 4) * 2 + (c >> 5), rr = r & 15, cc = c & 31, ob = rr * 64 + cc * 2; return st * 1024 + (ob ^ (((ob >> 9) & 1) << 5)); }
__host__ __device__ __forceinline__ void stage_rc(int b, int& R, int& C) { const int st = b / 1024, sb = b % 1024, swz = sb ^ (((sb >> 9) & 1) << 5); R = (st >> 1) * 16 + swz / 64; C = (st & 1) * 32 + (swz % 64) / 2; }
__host__ __device__ __forceinline__ int perm32(int rho) { const int n = rho >> 4, i = rho & 15; return 8 * (i >> 2) + 4 * n + (i & 3); }

struct Unit { int pm, pn; };
struct Gemm { const bf16_t* A; const bf16_t* Bt; int M, N, K, lda, ldb; };

struct StaticOrder {
    int nM, nN, nwg, G, c;
    __host__ __device__ void init(int M, int N, int G_, int c_) { nM = M / BM; nN = N / BM; nwg = nM * nN; G = G_; c = c_; }
    __host__ __device__ bool next(int i, Unit& u) const {
        const long L = (long)i * G + c; if (L >= nwg) return false;
        int wgid = (int)L; { const int q = nwg / NXCD, r = nwg % NXCD, xcd = wgid % NXCD, off = wgid / NXCD; wgid = (xcd < r ? xcd * (q + 1) : r * (q + 1) + (xcd - r) * q) + off; }
        const int nig = WGM * nN, gid = wgid / nig, fm = gid * WGM, gsz = (nM - fm) < WGM ? (nM - fm) : WGM;
        u.pm = fm + ((wgid % nig) % gsz); u.pn = (wgid % nig) / gsz; return true;
    }
};

__device__ __forceinline__ unsigned cvt_pk_bf16(float lo, float hi) { unsigned r; asm volatile("v_cvt_pk_bf16_f32 %0, %1, %2" : "=v"(r) : "v"(lo), "v"(hi)); return r; }
__device__ __forceinline__ f32x2 gelu_pk(f32x2 v) {
    const f32x2 av = __builtin_elementwise_abs(v), d = av * 0.2316418882f + 1.0f;
    f32x2 t; t.x = __builtin_amdgcn_rcpf(d.x); t.y = __builtin_amdgcn_rcpf(d.y);
    f32x2 q = t * 0.5307027145f + (-0.7265760135f); q = q * t + 0.7107068705f; q = q * t + (-0.142248368f); q = q * t + 0.127414796f; q = q * t;
    const f32x2 s = (v * v) * (-0.72134752044f);
    f32x2 e; e.x = __builtin_amdgcn_exp2f(s.x); e.y = __builtin_amdgcn_exp2f(s.y);
    const f32x2 m = v * (q * e), r = v - m;
    f32x2 o; o.x = v.x < 0.f ? m.x : r.x; o.y = v.y < 0.f ? m.y : r.y; return o;
}
__device__ __forceinline__ f32x4 gelu4(f32x4 v) { const f32x2 a = gelu_pk((f32x2){v[0], v[1]}), b = gelu_pk((f32x2){v[2], v[3]}); return (f32x4){a.x, a.y, b.x, b.y}; }

template <class Epi, class Sched>
__device__ __forceinline__ void gemm_phase(PG8_LAS unsigned char* lds, const Gemm g, const Sched& S, const Epi& E) {
    const int tid = threadIdx.x, wid = __builtin_amdgcn_readfirstlane(tid >> 6), lane = tid & 63, wr = wid >> 2, wc = wid & 3, fr = lane & 15, fq = lane >> 4;
    const int K = g.K, nt = K / BK;
    unsigned voffA[2], voffB[2];
#pragma unroll
    for (int i = 0; i < 2; ++i) { int R, C; stage_rc(tid * 16 + i * 8192, R, C); const int Rb = Epi::PERM ? ((R & ~31) + perm32(R & 31)) : R;
        voffA[i] = (unsigned)(R * g.lda + C) * 2u; voffB[i] = (unsigned)(Rb * g.ldb + C) * 2u; }
    const size_t kstep = (size_t)(BK * 2);
    const size_t hstepA = (size_t)HALF * g.lda * 2, hstepB = (size_t)HALF * g.ldb * 2;
    const size_t tstepA = 2 * hstepA, tstepB = 2 * hstepB;
    const unsigned ldsw = (unsigned)wid * 1024u;
    const int aoff = lds_byte(wr * 64 + fr, fq * 8), boff = lds_byte(wc * 32 + fr, fq * 8);
#define PG8_SA(b, h) (((b) * 2 + (h)) * HTB)
#define PG8_SB(b, h) ((4 + (b) * 2 + (h)) * HTB)
#define PG8_STAGE(bufoff, gbase, voff) do { _Pragma("unroll") for (int _i = 0; _i < 2; ++_i) \
        __builtin_amdgcn_global_load_lds((const unsigned*)((const char*)(gbase) + (voff)[_i]), (PG8_LAS unsigned*)(lds + (bufoff) + ldsw + _i * 8192), 16, 0, 0); } while (0)
#define PG8_LDA(dst, b, h) do { _Pragma("unroll") for (int m = 0; m < 4; ++m) _Pragma("unroll") for (int k = 0; k < 2; ++k) dst[m][k] = *(const PG8_LAS bf16x8*)(lds + PG8_SA(b, h) + aoff + m * 2048 + k * 1024); } while (0)
#define PG8_LDB(dst, b, h) do { _Pragma("unroll") for (int n = 0; n < 2; ++n) _Pragma("unroll") for (int k = 0; k < 2; ++k) dst[n][k] = *(const PG8_LAS bf16x8*)(lds + PG8_SB(b, h) + boff + n * 2048 + k * 1024); } while (0)
#define PG8_MMA(ai, bj, At, Bt) do { __builtin_amdgcn_s_setprio(1); _Pragma("unroll") for (int m = 0; m < 4; ++m) _Pragma("unroll") for (int n = 0; n < 2; ++n) _Pragma("unroll") for (int k = 0; k < 2; ++k) \
        acc[ai][bj][m][n] = __builtin_amdgcn_mfma_f32_16x16x32_bf16(Bt[n][k], At[m][k], acc[ai][bj][m][n], 0, 0, 0); __builtin_amdgcn_s_setprio(0); } while (0)
#define PG8_WAIT_V(n) asm volatile("s_waitcnt vmcnt(" #n ")" ::: "memory")
#define PG8_WAIT_L(n) asm volatile("s_waitcnt lgkmcnt(" #n ")" ::: "memory")
#define PG8_BAR __builtin_amdgcn_s_barrier()
#define PG8_SCHED __builtin_amdgcn_sched_barrier(0)
    Unit cur, nxt; int ui = 0;
    if (!S.next(0, cur)) return;
    f32x4 acc[2][2][4][2];
#pragma unroll
    for (int a = 0; a < 2; ++a)
#pragma unroll
        for (int b = 0; b < 2; ++b)
#pragma unroll
            for (int m = 0; m < 4; ++m)
#pragma unroll
                for (int n = 0; n < 2; ++n) acc[a][b][m][n] = (f32x4){0.f, 0.f, 0.f, 0.f};
    bf16x8 At[4][2], B0[2][2], B1[2][2];
    const char* cA = (const char*)g.A + (size_t)cur.pm * tstepA; const char* cB = (const char*)g.Bt + (size_t)cur.pn * tstepB;
    PG8_STAGE(PG8_SB(0, 0), cB, voffB); PG8_STAGE(PG8_SB(0, 1), cB + hstepB, voffB); PG8_STAGE(PG8_SA(0, 0), cA, voffA); PG8_STAGE(PG8_SA(0, 1), cA + hstepA, voffA);
    if (wr == 1) PG8_BAR;
    PG8_WAIT_V(2); PG8_BAR;
    PG8_STAGE(PG8_SB(1, 0), cB + kstep, voffB); PG8_STAGE(PG8_SA(1, 0), cA + kstep, voffA); PG8_STAGE(PG8_SB(1, 1), cB + hstepB + kstep, voffB);
    PG8_WAIT_V(6); PG8_BAR;
    for (;;) {
        const bool has_next = S.next(ui + 1, nxt);
        const char* nA = has_next ? (const char*)g.A + (size_t)nxt.pm * tstepA : cA; const char* nB = has_next ? (const char*)g.Bt + (size_t)nxt.pn * tstepB : cB;
        for (int t = 0; t < nt; t += 2) {
            const bool last = (t == nt - 2);
            const char* a1 = cA + (size_t)(t + 1) * kstep;
            const char* a2 = last ? nA : cA + (size_t)(t + 2) * kstep; const char* b2 = last ? nB : cB + (size_t)(t + 2) * kstep;
            const char* a3 = a2 + kstep; const char* b3 = b2 + kstep;
            PG8_LDB(B0, 0, 0); PG8_LDB(B1, 0, 1); PG8_SCHED; PG8_LDA(At, 0, 0); PG8_STAGE(PG8_SA(1, 1), a1 + hstepA, voffA);
            PG8_WAIT_V(8); PG8_WAIT_L(0); PG8_BAR; PG8_MMA(0, 0, At, B0); PG8_MMA(0, 1, At, B1); PG8_BAR; PG8_SCHED;
            PG8_LDA(At, 0, 1); PG8_STAGE(PG8_SB(0, 0), b2, voffB); PG8_STAGE(PG8_SB(0, 1), b2 + hstepB, voffB); PG8_STAGE(PG8_SA(0, 0), a2, voffA);
            PG8_WAIT_V(8); PG8_WAIT_L(0); PG8_BAR; PG8_MMA(1, 0, At, B0); PG8_MMA(1, 1, At, B1); PG8_BAR; PG8_SCHED;
            PG8_LDB(B0, 1, 0); PG8_LDB(B1, 1, 1); PG8_SCHED; PG8_LDA(At, 1, 0); PG8_STAGE(PG8_SA(0, 1), a2 + hstepA, voffA);
            PG8_WAIT_V(8); PG8_WAIT_L(0); PG8_BAR; PG8_MMA(0, 0, At, B0); PG8_MMA(0, 1, At, B1); PG8_BAR; PG8_SCHED;
            PG8_LDA(At, 1, 1); PG8_STAGE(PG8_SB(1, 0), b3, voffB); PG8_STAGE(PG8_SB(1, 1), b3 + hstepB, voffB); PG8_STAGE(PG8_SA(1, 0), a3, voffA);
            PG8_WAIT_V(8); PG8_WAIT_L(0); PG8_BAR; PG8_MMA(1, 0, At, B0); PG8_MMA(1, 1, At, B1); PG8_BAR; PG8_SCHED;
        }
        if (wr == 0) PG8_BAR;
        E(acc, cur, wr, wc, fr, fq);
        if (!has_next) break;
#pragma unroll
        for (int a = 0; a < 2; ++a)
#pragma unroll
            for (int b = 0; b < 2; ++b)
#pragma unroll
                for (int m = 0; m < 4; ++m)
#pragma unroll
                    for (int n = 0; n < 2; ++n) acc[a][b][m][n] = (f32x4){0.f, 0.f, 0.f, 0.f};
        cur = nxt; cA = nA; cB = nB; ++ui;
        if (wr == 1) PG8_BAR;
    }
    PG8_WAIT_V(0);
    PG8_BAR;
#undef PG8_SA
#undef PG8_SB
#undef PG8_STAGE
#undef PG8_LDA
#undef PG8_LDB
#undef PG8_MMA
#undef PG8_WAIT_V
#undef PG8_WAIT_L
#undef PG8_BAR
#undef PG8_SCHED
}
}

using pg8::bf16_t; using pg8::bf16x8; using pg8::f32x4; using pg8::f32x2; using pg8::u32x4; using pg8::u32x2; using pg8::cvt_pk_bf16; using pg8::Unit;
#define LAS __attribute__((address_space(3)))

constexpr int DM = 2048, DFF = 5632, DA = 1024, DB = 1024, DKV = 256, DIN = 7680;
constexpr int MP = 32768, MS = 256, MT = MP + MS, SEQ = 8192;
constexpr int MODW = 18432;
constexpr float EPS = 1e-6f;
constexpr int NWAVES = 8, NTHR = 512;
constexpr int LDS_BYTES = 147456;

constexpr size_t O_Y = 0, O_KP = (size_t)MT * DM, O_VP = O_KP + 131072, O_KS = O_VP + 131072, O_VS = O_KS + 262144, O_GV = O_VS + 262144, O_END = O_GV + 262144;

constexpr size_t MiB = 1u << 20;
constexpr size_t WS_MOD = 1 * MiB, WS_ROPE = 2 * MiB, WS_STATS = 3 * MiB;
constexpr size_t WS_W13 = 8 * MiB, WS_W2 = 52 * MiB, WS_WIN = 74 * MiB, WS_WPAB = 104 * MiB, WS_WO = 112 * MiB;
constexpr size_t WS_X1 = 120 * MiB, WS_H = 378 * MiB, WS_G = 507 * MiB;
constexpr size_t SZ_M1024 = (size_t)MT * 1024 * 2, SZ_M256 = (size_t)MT * 256 * 2, SZ_M2048 = (size_t)MT * 2048 * 2;
constexpr size_t WS_U = WS_G, WS_GV = WS_U + SZ_M1024, WS_Q = WS_GV + SZ_M1024, WS_K = WS_Q + SZ_M1024, WS_V = WS_K + SZ_M256, WS_GA = WS_V + SZ_M256, WS_GB = WS_GA + SZ_M2048, WS_END = WS_GB + SZ_M2048;
constexpr size_t WS_Y = WS_U;
constexpr size_t WS_AO = WS_H;
static_assert(WS_G + (size_t)MT * DFF * 2 <= 1024 * MiB && WS_END <= 1024 * MiB, "workspace map");
static_assert(WS_STATS + (size_t)MT * 16 * 8 <= WS_W13, "stats");

struct Args { const float* in[28]; float* out; unsigned char* ws; int ph_lo, ph_hi; };

__device__ __forceinline__ int mrow(int row) { return row < MP ? (row >> 13) : 4 + ((row - MP) >> 5); }
__device__ __forceinline__ float bf_lo(unsigned w) { return __uint_as_float(w << 16); }
__device__ __forceinline__ float bf_hi(unsigned w) { return __uint_as_float(w & 0xffff0000u); }
__device__ __forceinline__ float wave_sum(float v) {
#pragma unroll
    for (int o = 1; o < 64; o <<= 1) v += __shfl_xor(v, o);
    return v;
}
__device__ __forceinline__ float sigmoidf_(float x) { return __builtin_amdgcn_rcpf(1.0f + __expf(-x)); }

struct EpiSwiGLU {
    static constexpr bool PERM = true;
    bf16_t* G;
    __device__ __forceinline__ void operator()(const f32x4 (&acc)[2][2][4][2], const Unit& u, int wr, int wc, int fr, int fq) const {
        const int row0 = u.pm * 256 + wr * 64 + fr, col = u.pn * 128 + wc * 32 + 8 * fq;
#pragma unroll
        for (int ai = 0; ai < 2; ++ai)
#pragma unroll
            for (int m = 0; m < 4; ++m) {
                const int row = row0 + ai * 128 + m * 16;
                f32x4 r[2];
#pragma unroll
                for (int n = 0; n < 2; ++n) { const f32x4 a = acc[ai][0][m][n], b = acc[ai][1][m][n];
#pragma unroll
                    for (int e = 0; e < 4; ++e) r[n][e] = a[e] * b[e] * sigmoidf_(a[e]); }
                u32x4 w; w.x = cvt_pk_bf16(r[0][0], r[0][1]); w.y = cvt_pk_bf16(r[0][2], r[0][3]); w.z = cvt_pk_bf16(r[1][0], r[1][1]); w.w = cvt_pk_bf16(r[1][2], r[1][3]);
                *(u32x4*)(G + (size_t)row * DFF + col) = w;
            }
    }
};

struct EpiResid {
    static constexpr bool PERM = false;
    const float* baseP; const float* baseS; float* out; const float* gate; float coef;
    __device__ __forceinline__ void operator()(const f32x4 (&acc)[2][2][4][2], const Unit& u, int wr, int wc, int fr, int fq) const {
        const int pm = u.pm; const bool uni = pm < 128;
        const int colb = u.pn * 256 + wc * 32 + 4 * fq;
        f32x4 gv[2][2];
#pragma unroll
        for (int bj = 0; bj < 2; ++bj)
#pragma unroll
            for (int n = 0; n < 2; ++n) gv[bj][n] = *(const f32x4*)(gate + (size_t)(uni ? (pm >> 5) : 4) * MODW + colb + bj * 128 + n * 16) * coef;
#pragma unroll
        for (int ai = 0; ai < 2; ++ai)
#pragma unroll
            for (int m = 0; m < 4; ++m) {
                const int row = pm * 256 + ai * 128 + wr * 64 + m * 16 + fr;
                const float* bp = row < MP ? baseP + (size_t)row * DM : baseS + (size_t)(row - MP) * DM;
                const int mr = mrow(row);
#pragma unroll
                for (int bj = 0; bj < 2; ++bj)
#pragma unroll
                    for (int n = 0; n < 2; ++n) { const int col = colb + bj * 128 + n * 16;
                        f32x4 gg = gv[bj][n]; if (!uni) gg = *(const f32x4*)(gate + (size_t)mr * MODW + col) * coef;
                        const f32x4 b = *(const f32x4*)(bp + col);
                        *(f32x4*)(out + (size_t)row * DM + col) = b + gg * acc[ai][bj][m][n]; }
            }
    }
};

struct EpiMerge1 {
    static constexpr bool PERM = false;
    const bf16_t* GA; float* T;
    __device__ __forceinline__ void operator()(const f32x4 (&acc)[2][2][4][2], const Unit& u, int wr, int wc, int fr, int fq) const {
        const int colb = u.pn * 256 + wc * 32 + 4 * fq;
#pragma unroll
        for (int ai = 0; ai < 2; ++ai)
#pragma unroll
            for (int m = 0; m < 4; ++m) {
                const size_t ro = (size_t)(u.pm * 256 + ai * 128 + wr * 64 + m * 16 + fr) * DM;
#pragma unroll
                for (int bj = 0; bj < 2; ++bj)
#pragma unroll
                    for (int n = 0; n < 2; ++n) { const int col = colb + bj * 128 + n * 16;
                        const u32x2 gw = *(const u32x2*)(GA + ro + col);
                        const f32x4 gg = (f32x4){bf_lo(gw.x), bf_hi(gw.x), bf_lo(gw.y), bf_hi(gw.y)};
                        *(f32x4*)(T + ro + col) = gg * acc[ai][bj][m][n]; }
            }
    }
};
struct EpiMerge2 {
    static constexpr bool PERM = false;
    const bf16_t* GB; const float* T; bf16_t* Y;
    __device__ __forceinline__ void operator()(const f32x4 (&acc)[2][2][4][2], const Unit& u, int wr, int wc, int fr, int fq) const {
        const int colb = u.pn * 256 + wc * 32 + 4 * fq;
#pragma unroll
        for (int ai = 0; ai < 2; ++ai)
#pragma unroll
            for (int m = 0; m < 4; ++m) {
                const size_t ro = (size_t)(u.pm * 256 + ai * 128 + wr * 64 + m * 16 + fr) * DM;
#pragma unroll
                for (int bj = 0; bj < 2; ++bj)
#pragma unroll
                    for (int n = 0; n < 2; ++n) { const int col = colb + bj * 128 + n * 16;
                        const u32x2 gw = *(const u32x2*)(GB + ro + col);
                        const f32x4 gg = (f32x4){bf_lo(gw.x), bf_hi(gw.x), bf_lo(gw.y), bf_hi(gw.y)};
                        const f32x4 r = *(const f32x4*)(T + ro + col) + gg * acc[ai][bj][m][n];
                        u32x2 w; w.x = cvt_pk_bf16(r[0], r[1]); w.y = cvt_pk_bf16(r[2], r[3]);
                        *(u32x2*)(Y + ro + col) = w; }
            }
    }
};

struct EpiWin {
    static constexpr bool PERM = true;
    unsigned char* ws; f32x2* stats; const float* gq; const float* gk; const f32x2* rope; float* out;
    __device__ __forceinline__ void operator()(const f32x4 (&acc)[2][2][4][2], const Unit& u, int wr, int wc, int fr, int fq) const {
        const int pn = u.pn, row0 = u.pm * 256 + wr * 64 + fr, cw = wc * 32 + 8 * fq;
        if (pn < 8) {
            bf16_t* dst = (bf16_t*)(ws + WS_U + (pn < 4 ? (size_t)0 : SZ_M1024)) + (pn & 3) * 256 + cw;
#pragma unroll
            for (int ai = 0; ai < 2; ++ai)
#pragma unroll
                for (int m = 0; m < 4; ++m) {
                    const int row = row0 + ai * 128 + m * 16; float s1 = 0.f, s2 = 0.f;
#pragma unroll
                    for (int bj = 0; bj < 2; ++bj) {
                        const f32x4 v0 = pg8::gelu4(acc[ai][bj][m][0]), v1 = pg8::gelu4(acc[ai][bj][m][1]);
                        s1 += (v0[0] + v0[1]) + (v0[2] + v0[3]) + (v1[0] + v1[1]) + (v1[2] + v1[3]);
                        s2 += (v0[0] * v0[0] + v0[1] * v0[1]) + (v0[2] * v0[2] + v0[3] * v0[3]) + (v1[0] * v1[0] + v1[1] * v1[1]) + (v1[2] * v1[2] + v1[3] * v1[3]);
                        u32x4 w; w.x = cvt_pk_bf16(v0[0], v0[1]); w.y = cvt_pk_bf16(v0[2], v0[3]); w.z = cvt_pk_bf16(v1[0], v1[1]); w.w = cvt_pk_bf16(v1[2], v1[3]);
                        *(u32x4*)(dst + (size_t)row * 1024 + bj * 128) = w;
                    }
                    if (pn >= 4) {
                        s1 += __shfl_xor(s1, 16); s1 += __shfl_xor(s1, 32); s2 += __shfl_xor(s2, 16); s2 += __shfl_xor(s2, 32);
                        if (fq == 0) stats[(size_t)row * 16 + (pn - 4) * 4 + wc] = (f32x2){s1, s2};
                    }
                }
        } else if (pn < 14) {
            const int t = pn - 8; const bool isq = t < 4, isk = t == 4, isv = t == 5;
            const float* gvec = isq ? gq : gk;
            f32x4 gg[2][2];
#pragma unroll
            for (int bj = 0; bj < 2; ++bj)
#pragma unroll
                for (int n = 0; n < 2; ++n) gg[bj][n] = *(const f32x4*)(gvec + 32 * bj + 8 * fq + 4 * n);
#pragma unroll
            for (int ai = 0; ai < 2; ++ai)
#pragma unroll
                for (int m = 0; m < 4; ++m) {
                    const int row = row0 + ai * 128 + m * 16;
                    f32x4 x[2][2];
#pragma unroll
                    for (int bj = 0; bj < 2; ++bj)
#pragma unroll
                        for (int n = 0; n < 2; ++n) x[bj][n] = acc[ai][bj][m][n];
                    if (!isv) {
                        float ss = 0.f;
#pragma unroll
                        for (int bj = 0; bj < 2; ++bj)
#pragma unroll
                            for (int n = 0; n < 2; ++n) ss += (x[bj][n][0] * x[bj][n][0] + x[bj][n][1] * x[bj][n][1]) + (x[bj][n][2] * x[bj][n][2] + x[bj][n][3] * x[bj][n][3]);
                        ss += __shfl_xor(ss, 16); ss += __shfl_xor(ss, 32);
                        const float rstd = rsqrtf(ss * (1.0f / 64.0f) + EPS);
#pragma unroll
                        for (int bj = 0; bj < 2; ++bj)
#pragma unroll
                            for (int n = 0; n < 2; ++n) x[bj][n] = x[bj][n] * rstd * gg[bj][n];
                        const int pos = row < MP ? (row & (SEQ - 1)) : 2048 + ((row - MP) & 31);
                        f32x4 pr[2];
#pragma unroll
                        for (int n = 0; n < 2; ++n)
#pragma unroll
                            for (int e = 0; e < 4; ++e) pr[n][e] = __shfl_xor(x[0][n][e], 16);
                        if (fq < 2) {
                            const float sgn = fq == 0 ? -1.0f : 1.0f;
#pragma unroll
                            for (int n = 0; n < 2; ++n) {
                                const f32x4 c01 = *(const f32x4*)(rope + (size_t)pos * 8 + 4 * n), c23 = *(const f32x4*)(rope + (size_t)pos * 8 + 4 * n + 2);
                                x[0][n][0] = x[0][n][0] * c01[0] + sgn * pr[n][0] * c01[1];
                                x[0][n][1] = x[0][n][1] * c01[2] + sgn * pr[n][1] * c01[3];
                                x[0][n][2] = x[0][n][2] * c23[0] + sgn * pr[n][2] * c23[1];
                                x[0][n][3] = x[0][n][3] * c23[2] + sgn * pr[n][3] * c23[3];
                            }
                        }
                    }
                    bf16_t* dst = isq ? (bf16_t*)(ws + WS_Q) + (size_t)row * 1024 + (4 * t + wc) * 64 : (bf16_t*)(ws + WS_K + (isk ? (size_t)0 : SZ_M256)) + (size_t)row * 256 + wc * 64;
#pragma unroll
                    for (int bj = 0; bj < 2; ++bj) {
                        u32x4 w; w.x = cvt_pk_bf16(x[bj][0][0], x[bj][0][1]); w.y = cvt_pk_bf16(x[bj][0][2], x[bj][0][3]); w.z = cvt_pk_bf16(x[bj][1][0], x[bj][1][1]); w.w = cvt_pk_bf16(x[bj][1][2], x[bj][1][3]);
                        *(u32x4*)(dst + 32 * bj + 8 * fq) = w;
                    }
                    if (!isq) {
                        float* o = nullptr;
                        if (row < MP) { const int tp = row & (SEQ - 1); if (tp >= SEQ - 128) o = out + (isk ? O_KP : O_VP) + ((size_t)((row >> 13) * 128 + tp - (SEQ - 128)) * 4 + wc) * 64; }
                        else { const int j = (row - MP) & 31, b = (row - MP) >> 5; o = out + (isk ? O_KS : O_VS) + ((size_t)(b * 128 + 96 + j) * 4 + wc) * 64; }
                        if (o) {
#pragma unroll
                            for (int bj = 0; bj < 2; ++bj)
#pragma unroll
                                for (int n = 0; n < 2; ++n) *(f32x4*)(o + 32 * bj + 8 * fq + 4 * n) = x[bj][n];
                        }
                    }
                }
        } else {
            bf16_t* dst = (bf16_t*)(ws + WS_GA + (pn < 22 ? (size_t)0 : SZ_M2048)) + ((pn - 14) & 7) * 256 + cw;
#pragma unroll
            for (int ai = 0; ai < 2; ++ai)
#pragma unroll
                for (int m = 0; m < 4; ++m) {
                    const int row = row0 + ai * 128 + m * 16;
#pragma unroll
                    for (int bj = 0; bj < 2; ++bj) {
                        f32x4 v0 = acc[ai][bj][m][0], v1 = acc[ai][bj][m][1];
#pragma unroll
                        for (int e = 0; e < 4; ++e) { v0[e] = sigmoidf_(v0[e]); v1[e] = sigmoidf_(v1[e]); }
                        u32x4 w; w.x = cvt_pk_bf16(v0[0], v0[1]); w.y = cvt_pk_bf16(v0[2], v0[3]); w.z = cvt_pk_bf16(v1[0], v1[1]); w.w = cvt_pk_bf16(v1[2], v1[3]);
                        *(u32x4*)(dst + (size_t)row * 2048 + bj * 128) = w;
                    }
                }
        }
    }
};

__device__ __forceinline__ void transpose_item(const float* W, int N, int k0, int n0, bf16_t* dst  , int ld, LAS float* scr, int lane) {
#pragma unroll 8
    for (int i = 0; i < 32; ++i) { const int kk = 2 * i + (lane >> 5); scr[kk * 33 + (lane & 31)] = W[(size_t)(k0 + kk) * N + n0 + (lane & 31)]; }
    asm volatile("s_waitcnt lgkmcnt(0)" ::: "memory");
    const int c = lane & 7;
#pragma unroll
    for (int j = 0; j < 4; ++j) { const int n = (lane >> 3) + 8 * j; const LAS float* s = scr + (8 * c) * 33 + n;
        u32x4 o; o.x = cvt_pk_bf16(s[0 * 33], s[1 * 33]); o.y = cvt_pk_bf16(s[2 * 33], s[3 * 33]); o.z = cvt_pk_bf16(s[4 * 33], s[5 * 33]); o.w = cvt_pk_bf16(s[6 * 33], s[7 * 33]);
        *(u32x4*)(dst + (size_t)n * ld + 8 * c) = o; }
    asm volatile("s_waitcnt lgkmcnt(0)" ::: "memory");
}
__device__ __forceinline__ void tr_mat(int r, const float* W, int K, int N, bf16_t* dst, int ld, int coff, int kind, LAS float* scr, int lane) {
    const int nblk = N / 32, kb = r / nblk, nb = r - kb * nblk, k0 = 64 * kb, n0 = 32 * nb;
    int drow = n0;
    if (kind == 1) drow = 256 * (n0 >> 7) + (n0 & 127);
    else if (kind == 2) drow = 256 * (n0 >> 7) + 128 + (n0 & 127);
    else if (kind == 3) { if (n0 >= 2048 && n0 < 3584) { const int t = n0 - 2048, tile = t >> 8, o = t & 255; drow = 2048 + 256 * tile + 128 * ((o >> 5) & 1) + 32 * (o >> 6); } }
    transpose_item(W, N, k0, n0, dst + (size_t)drow * ld + coff + k0, ld, scr, lane);
}
constexpr int IT_FFN13 = (DM / 64) * (DFF / 32), IT_FFN2 = (DFF / 64) * (DM / 32), IT_WIN = (DM / 64) * (DIN / 32), IT_WP = (DA / 64) * (DM / 32), IT_WO = (DM / 64) * (DM / 32);
__device__ __forceinline__ void transpose_ffn(const float* w1, const float* w3, const float* w2, unsigned char* ws, LAS float* scr, int gw, int NGW, int lane) {
    for (int it = gw; it < 2 * IT_FFN13 + IT_FFN2; it += NGW) {
        int r = it;
        if (r < IT_FFN13) { tr_mat(r, w1, DM, DFF, (bf16_t*)(ws + WS_W13), DM, 0, 1, scr, lane); continue; } r -= IT_FFN13;
        if (r < IT_FFN13) { tr_mat(r, w3, DM, DFF, (bf16_t*)(ws + WS_W13), DM, 0, 2, scr, lane); continue; } r -= IT_FFN13;
        tr_mat(r, w2, DFF, DM, (bf16_t*)(ws + WS_W2), DFF, 0, 0, scr, lane);
    }
}

__device__ __forceinline__ void norm_phase(const float* srcP, const float* srcS, const float* g, const float* mod, int sub, bf16_t* H, int gw, int NGW, int lane) {
    const int R = (MT + NGW - 1) / NGW, r0 = gw * R, r1 = (r0 + R < MT) ? r0 + R : MT;
    if (r0 >= r1) return;
    int cur = -1; f32x4 gs[8], sh[8], v[8], nv[8];
    { const f32x4* xr = (const f32x4*)(r0 < MP ? srcP + (size_t)r0 * DM : srcS + (size_t)(r0 - MP) * DM) + lane;
#pragma unroll
      for (int j = 0; j < 8; ++j) v[j] = xr[64 * j]; }
    for (int r = r0; r < r1; ++r) {
        if (r + 1 < r1) { const int rn = r + 1; const f32x4* xr = (const f32x4*)(rn < MP ? srcP + (size_t)rn * DM : srcS + (size_t)(rn - MP) * DM) + lane;
#pragma unroll
            for (int j = 0; j < 8; ++j) nv[j] = xr[64 * j]; }
        const int mr = mrow(r);
        if (mr != cur) { cur = mr; const f32x4* g4 = (const f32x4*)g + lane; const f32x4* m4 = (const f32x4*)(mod + (size_t)mr * MODW + sub * 3 * DM) + lane;
#pragma unroll
            for (int j = 0; j < 8; ++j) { gs[j] = g4[64 * j] * (m4[512 + 64 * j] + 1.0f); sh[j] = m4[64 * j]; } }
        float ss = 0.f;
#pragma unroll
        for (int j = 0; j < 8; ++j) ss += (v[j][0] * v[j][0] + v[j][1] * v[j][1]) + (v[j][2] * v[j][2] + v[j][3] * v[j][3]);
        const float rstd = rsqrtf(wave_sum(ss) * (1.0f / DM) + EPS);
        u32x2* o = (u32x2*)(H + (size_t)r * DM) + lane;
#pragma unroll
        for (int j = 0; j < 8; ++j) { const f32x4 h = v[j] * rstd * gs[j] + sh[j]; u32x2 w; w.x = cvt_pk_bf16(h[0], h[1]); w.y = cvt_pk_bf16(h[2], h[3]); o[64 * j] = w; }
#pragma unroll
        for (int j = 0; j < 8; ++j) v[j] = nv[j];
    }
}

constexpr int VNT_LD = 136;
constexpr int KS_LD = 72;
constexpr int VT_LD = 200;
constexpr int VT_OFF = 192 * KS_LD * 2;

__device__ __forceinline__ void spatial_unit(LAS unsigned char* lds, const Args& a, int row0, int nrows, int g, int sb) {
    const int tid = threadIdx.x, w = __builtin_amdgcn_readfirstlane(tid >> 6), lane = tid & 63;
    unsigned char* ws = a.ws;
    const bf16_t* GV = (const bf16_t*)(ws + WS_GV); const bf16_t* U = (const bf16_t*)(ws + WS_U); bf16_t* AO = (bf16_t*)(ws + WS_AO);
    const f32x2* stats = (const f32x2*)(ws + WS_STATS);
    const float* lng = a.in[16]; const float* lnb = a.in[17]; const float* w_s = a.in[18]; const float* b_s = a.in[19];
    LAS bf16_t* vnT = (LAS bf16_t*)lds;
    __syncthreads();
    {
        const int j = tid >> 2, cq = tid & 3;
        if (j < nrows) {
            const int row = row0 + j;
            const f32x4* st = (const f32x4*)(stats + (size_t)row * 16);
            float s1 = 0.f, s2 = 0.f;
#pragma unroll
            for (int i = 0; i < 8; ++i) { const f32x4 p = st[i]; s1 += p[0] + p[2]; s2 += p[1] + p[3]; }
            const float mean = s1 * (1.0f / 1024.0f), var = s2 * (1.0f / 1024.0f) - mean * mean, rstd = rsqrtf(var + EPS);
            const u32x4* src = (const u32x4*)(GV + (size_t)row * 1024 + 128 * g + 32 * cq);
#pragma unroll
            for (int q = 0; q < 4; ++q) {
                const u32x4 pk = src[q]; const int c0 = 32 * cq + 8 * q;
                const f32x4 ga = *(const f32x4*)(lng + 128 * g + c0), gb = *(const f32x4*)(lng + 128 * g + c0 + 4), ba = *(const f32x4*)(lnb + 128 * g + c0), bb = *(const f32x4*)(lnb + 128 * g + c0 + 4);
                f32x4 x0 = (f32x4){bf_lo(pk.x), bf_hi(pk.x), bf_lo(pk.y), bf_hi(pk.y)}, x1 = (f32x4){bf_lo(pk.z), bf_hi(pk.z), bf_lo(pk.w), bf_hi(pk.w)};
                x0 = (x0 - mean) * rstd * ga + ba; x1 = (x1 - mean) * rstd * gb + bb;
                if (sb >= 0) { float* o = a.out + O_GV + (size_t)(sb * 32 + j) * 1024 + 128 * g + c0; *(f32x4*)o = x0; *(f32x4*)(o + 4) = x1; }
                const unsigned p0 = cvt_pk_bf16(x0[0], x0[1]), p1 = cvt_pk_bf16(x0[2], x0[3]), p2 = cvt_pk_bf16(x1[0], x1[1]), p3 = cvt_pk_bf16(x1[2], x1[3]);
                vnT[(c0 + 0) * VNT_LD + j] = (bf16_t)(p0 & 0xffff); vnT[(c0 + 1) * VNT_LD + j] = (bf16_t)(p0 >> 16);
                vnT[(c0 + 2) * VNT_LD + j] = (bf16_t)(p1 & 0xffff); vnT[(c0 + 3) * VNT_LD + j] = (bf16_t)(p1 >> 16);
                vnT[(c0 + 4) * VNT_LD + j] = (bf16_t)(p2 & 0xffff); vnT[(c0 + 5) * VNT_LD + j] = (bf16_t)(p2 >> 16);
                vnT[(c0 + 6) * VNT_LD + j] = (bf16_t)(p3 & 0xffff); vnT[(c0 + 7) * VNT_LD + j] = (bf16_t)(p3 >> 16);
            }
        } else {
#pragma unroll 8
            for (int c = 0; c < 32; ++c) vnT[(32 * cq + c) * VNT_LD + j] = (bf16_t)0;
        }
    }
    const int il = lane & 15, kg = lane >> 4, i = 16 * w + il;
    const int nks = (sb >= 0) ? 1 : (w < 4 ? 2 : 4);
    bf16x8 Bf[4];
#pragma unroll
    for (int ks = 0; ks < 4; ++ks) {
        if (ks < nks) { const float* wp = w_s + (size_t)g * 16384 + i * 128 + 32 * ks + 8 * kg; const f32x4 a0 = *(const f32x4*)wp, a1 = *(const f32x4*)(wp + 4);
            u32x4 pk; pk.x = cvt_pk_bf16(a0[0], a0[1]); pk.y = cvt_pk_bf16(a0[2], a0[3]); pk.z = cvt_pk_bf16(a1[0], a1[1]); pk.w = cvt_pk_bf16(a1[2], a1[3]);
            Bf[ks] = __builtin_bit_cast(bf16x8, pk); }
        else Bf[ks] = (bf16x8){0, 0, 0, 0, 0, 0, 0, 0};
    }
    __syncthreads();
    if (sb >= 0 && w >= 2) return;
    f32x4 acc[8];
#pragma unroll
    for (int cb = 0; cb < 8; ++cb) {
        acc[cb] = (f32x4){0.f, 0.f, 0.f, 0.f};
#pragma unroll
        for (int ks = 0; ks < 4; ++ks)
            if (ks < nks) { const bf16x8 Af = *(const LAS bf16x8*)(vnT + (16 * cb + il) * VNT_LD + 32 * ks + 8 * kg);
                acc[cb] = __builtin_amdgcn_mfma_f32_16x16x32_bf16(Af, Bf[ks], acc[cb], 0, 0, 0); }
    }
    if (i < nrows) {
        const float bs = b_s[g * 128 + i]; const size_t row = (size_t)(row0 + i);
#pragma unroll
        for (int cb = 0; cb < 8; ++cb) {
            const int c = 128 * g + 16 * cb + 4 * kg;
            const u32x2 uw = *(const u32x2*)(U + row * 1024 + c);
            const f32x4 uu = (f32x4){bf_lo(uw.x), bf_hi(uw.x), bf_lo(uw.y), bf_hi(uw.y)};
            const f32x4 r = uu * (acc[cb] + bs);
            u32x2 o; o.x = cvt_pk_bf16(r[0], r[1]); o.y = cvt_pk_bf16(r[2], r[3]);
            *(u32x2*)(AO + row * 2048 + c) = o;
        }
    }
}

__device__ __forceinline__ void attn_unit(LAS unsigned char* lds, const Args& a, int b, int cn, int kvh, int sb) {
    const int tid = threadIdx.x, w = __builtin_amdgcn_readfirstlane(tid >> 6), lane = tid & 63, il = lane & 15, kg = lane >> 4;
    unsigned char* ws = a.ws;
    const bf16_t* Q = (const bf16_t*)(ws + WS_Q); const bf16_t* Kb = (const bf16_t*)(ws + WS_K); const bf16_t* Vb = (const bf16_t*)(ws + WS_V); bf16_t* AO = (bf16_t*)(ws + WS_AO);
    LAS bf16_t* Ks = (LAS bf16_t*)lds; LAS bf16_t* VT = (LAS bf16_t*)(lds + VT_OFF);
    const bool samp = sb >= 0;
    __syncthreads();
#pragma unroll
    for (int p = 0; p < 3; ++p) {
        const int idx = p * NTHR + tid, key = idx >> 3, part = idx & 7;
        u32x4 k8 = (u32x4){0u, 0u, 0u, 0u}, v8 = (u32x4){0u, 0u, 0u, 0u};
        if (!samp) {
            const int pos = 64 * (cn - 2) + key;
            if (pos >= 0) { const size_t off = (size_t)(b * SEQ + pos) * 256 + kvh * 64 + part * 8; k8 = *(const u32x4*)(Kb + off); v8 = *(const u32x4*)(Vb + off); }
        } else if (key < 128) {
            const size_t off = ((size_t)(sb * 128 + key) * 4 + kvh) * 64 + part * 8;
            const f32x4 k0 = *(const f32x4*)(a.in[2] + off), k1 = *(const f32x4*)(a.in[2] + off + 4), v0 = *(const f32x4*)(a.in[3] + off), v1 = *(const f32x4*)(a.in[3] + off + 4);
            k8.x = cvt_pk_bf16(k0[0], k0[1]); k8.y = cvt_pk_bf16(k0[2], k0[3]); k8.z = cvt_pk_bf16(k1[0], k1[1]); k8.w = cvt_pk_bf16(k1[2], k1[3]);
            v8.x = cvt_pk_bf16(v0[0], v0[1]); v8.y = cvt_pk_bf16(v0[2], v0[3]); v8.z = cvt_pk_bf16(v1[0], v1[1]); v8.w = cvt_pk_bf16(v1[2], v1[3]);
        } else if (key < 160) {
            const size_t off = (size_t)(MP + sb * 32 + key - 128) * 256 + kvh * 64 + part * 8; k8 = *(const u32x4*)(Kb + off); v8 = *(const u32x4*)(Vb + off);
        }
        *(LAS u32x4*)(Ks + key * KS_LD + part * 8) = k8;
        LAS bf16_t* vt = VT + (part * 8) * VT_LD + key;
        vt[0 * VT_LD] = (bf16_t)(v8.x & 0xffff); vt[1 * VT_LD] = (bf16_t)(v8.x >> 16); vt[2 * VT_LD] = (bf16_t)(v8.y & 0xffff); vt[3 * VT_LD] = (bf16_t)(v8.y >> 16);
        vt[4 * VT_LD] = (bf16_t)(v8.z & 0xffff); vt[5 * VT_LD] = (bf16_t)(v8.z >> 16); vt[6 * VT_LD] = (bf16_t)(v8.w & 0xffff); vt[7 * VT_LD] = (bf16_t)(v8.w >> 16);
    }
    const int hq = 4 * kvh + (w >> 1);
    const int qrow0 = samp ? MP + sb * 32 + (w & 1) * 16 : b * SEQ + 64 * cn + (w & 1) * 32;
    const int kb_lo = samp ? 0 : (cn < 2 ? 4 * (2 - cn) : 0), kb_hi = samp ? 10 : 12;
    bf16x8 Qf[2][2];
#pragma unroll
    for (int qb = 0; qb < 2; ++qb) { const int row = qrow0 + ((samp && qb) ? 0 : 16 * qb) + il;
#pragma unroll
        for (int ks = 0; ks < 2; ++ks) Qf[qb][ks] = *(const bf16x8*)(Q + (size_t)row * 1024 + hq * 64 + 32 * ks + 8 * kg); }
    __syncthreads();
    f32x4 S[2][12];
#pragma unroll
    for (int kb = 0; kb < 12; ++kb) {
#pragma unroll
        for (int qb = 0; qb < 2; ++qb) S[qb][kb] = (f32x4){0.f, 0.f, 0.f, 0.f};
        if (kb >= kb_lo && kb < kb_hi) {
#pragma unroll
            for (int ks = 0; ks < 2; ++ks) { const bf16x8 Kf = *(const LAS bf16x8*)(Ks + (16 * kb + il) * KS_LD + 32 * ks + 8 * kg);
#pragma unroll
                for (int qb = 0; qb < 2; ++qb) S[qb][kb] = __builtin_amdgcn_mfma_f32_16x16x32_bf16(Kf, Qf[qb][ks], S[qb][kb], 0, 0, 0); }
        }
    }
    const float sink = a.in[20][hq];
    float linv[2];
#pragma unroll
    for (int qb = 0; qb < 2; ++qb) {
        float mx = sink;
#pragma unroll
        for (int kb = 0; kb < 12; ++kb) if (kb >= kb_lo && kb < kb_hi) {
#pragma unroll
            for (int e = 0; e < 4; ++e) { S[qb][kb][e] *= 0.125f; mx = fmaxf(mx, S[qb][kb][e]); } }
        mx = fmaxf(mx, __shfl_xor(mx, 16)); mx = fmaxf(mx, __shfl_xor(mx, 32));
        float l = 0.f;
#pragma unroll
        for (int kb = 0; kb < 12; ++kb) {
            if (kb >= kb_lo && kb < kb_hi) {
#pragma unroll
                for (int e = 0; e < 4; ++e) { const float p = __expf(S[qb][kb][e] - mx); S[qb][kb][e] = p; l += p; }
            } else S[qb][kb] = (f32x4){0.f, 0.f, 0.f, 0.f};
        }
        l += __shfl_xor(l, 16); l += __shfl_xor(l, 32);
        l += __expf(sink - mx);
        linv[qb] = 1.0f / l;
    }
    f32x4 O[2][4];
#pragma unroll
    for (int qb = 0; qb < 2; ++qb)
#pragma unroll
        for (int db = 0; db < 4; ++db) O[qb][db] = (f32x4){0.f, 0.f, 0.f, 0.f};
#pragma unroll
    for (int t = 0; t < 6; ++t) {
        if (2 * t + 1 >= kb_lo && 2 * t < kb_hi) {
            bf16x8 Pf[2];
#pragma unroll
            for (int qb = 0; qb < 2; ++qb) { u32x4 pk; pk.x = cvt_pk_bf16(S[qb][2 * t][0], S[qb][2 * t][1]); pk.y = cvt_pk_bf16(S[qb][2 * t][2], S[qb][2 * t][3]);
                pk.z = cvt_pk_bf16(S[qb][2 * t + 1][0], S[qb][2 * t + 1][1]); pk.w = cvt_pk_bf16(S[qb][2 * t + 1][2], S[qb][2 * t + 1][3]); Pf[qb] = __builtin_bit_cast(bf16x8, pk); }
#pragma unroll
            for (int db = 0; db < 4; ++db) {
                const LAS bf16_t* vp = VT + (16 * db + il) * VT_LD + 32 * t + 4 * kg;
                const u32x2 lo = *(const LAS u32x2*)vp, hi = *(const LAS u32x2*)(vp + 16);
                const bf16x8 Vf = __builtin_bit_cast(bf16x8, (u32x4){lo.x, lo.y, hi.x, hi.y});
#pragma unroll
                for (int qb = 0; qb < 2; ++qb) O[qb][db] = __builtin_amdgcn_mfma_f32_16x16x32_bf16(Vf, Pf[qb], O[qb][db], 0, 0, 0);
            }
        }
    }
#pragma unroll
    for (int qb = 0; qb < 2; ++qb) {
        if (samp && qb) continue;
        const size_t row = (size_t)(qrow0 + 16 * qb + il);
#pragma unroll
        for (int db = 0; db < 4; ++db) { const f32x4 r = O[qb][db] * linv[qb]; u32x2 o; o.x = cvt_pk_bf16(r[0], r[1]); o.y = cvt_pk_bf16(r[2], r[3]);
            *(u32x2*)(AO + row * 2048 + 1024 + hq * 64 + 16 * db + 4 * kg) = o; }
    }
}


#define XB_TMO      128
#define XB_XCNT(j)  (256  + 64 * (j))
#define XB_XSUB(j)  (1280 + 64 * (j))
#define XB_XGEN(j)  (2304 + 64 * (j))
#define XB_TOP      3328
#define XB_TOPGEN   3392
#define XCD_BAR_WORDS 3456
#define XB_SPIN_CAP (1u << 18)
__device__ __forceinline__ unsigned xb_ld(unsigned* p)              { return __hip_atomic_load(p, __ATOMIC_RELAXED, __HIP_MEMORY_SCOPE_AGENT); }
__device__ __forceinline__ unsigned xb_add(unsigned* p, unsigned v) { return __hip_atomic_fetch_add(p, v, __ATOMIC_RELAXED, __HIP_MEMORY_SCOPE_AGENT); }
__device__ __forceinline__ unsigned xb_xcc_id() { return (unsigned)__builtin_amdgcn_s_getreg((3 << 11) | 20) & 0xFu; }
#define XB_SPIN(cond, bar) do { unsigned _sp = 0; while (cond) { __builtin_amdgcn_s_sleep(1); \
    if ((++_sp & 255u) == 0u) { if (xb_ld(&(bar)[XB_TMO])) break; if (_sp > XB_SPIN_CAP) { atomicAdd(&(bar)[XB_TMO], 1u); break; } } } } while (0)
struct XcdBarrier { unsigned* bar; unsigned x; volatile LAS unsigned* st; };
__device__ __forceinline__ XcdBarrier xcd_barrier_post(unsigned* bar, volatile LAS unsigned* st) {
    XcdBarrier b; b.bar = bar; b.x = xb_xcc_id(); b.st = st;
    if (threadIdx.x == 0) (void)xb_add(&bar[XB_XCNT(b.x)], 1u);
    return b;
}
__device__ __forceinline__ void xcd_barrier_complete(unsigned* bar, unsigned x, unsigned& nloc, unsigned& nx) {
    const unsigned G = gridDim.x * gridDim.y * gridDim.z;
    unsigned sum, cnt, mine, sp = 0u;
    for (;;) {
        sum = 0u; cnt = 0u; mine = 0u;
#pragma unroll
        for (unsigned j = 0; j < 16; ++j) { const unsigned c = xb_ld(&bar[XB_XCNT(j)]); sum += c; cnt += (c > 0u) ? 1u : 0u; mine = (j == x) ? c : mine; }
        if (sum == G) break;
        __builtin_amdgcn_s_sleep(1);
        if ((++sp & 255u) == 0u) { if (xb_ld(&bar[XB_TMO])) break; if (sp > XB_SPIN_CAP) { atomicAdd(&bar[XB_TMO], 1u); break; } }
    }
    nloc = mine > 0u ? mine : 1u; nx = cnt > 0u ? cnt : 1u;
}
__device__ __forceinline__ void xcd_barrier(const XcdBarrier& b) {
    asm volatile("s_waitcnt vmcnt(0)" ::: "memory");
    __syncthreads();
    if (threadIdx.x == 0) {
        unsigned* bar = b.bar;
        __builtin_amdgcn_s_waitcnt(0);
        unsigned nloc = b.st[0], nx = b.st[1];
        if (nloc == 0u) { xcd_barrier_complete(bar, b.x, nloc, nx); b.st[0] = nloc; b.st[1] = nx; }
        const unsigned old = xb_add(&bar[XB_XSUB(b.x)], 1u);
        const unsigned gen = old / nloc;
        if (old + 1u == (gen + 1u) * nloc) {
            __builtin_amdgcn_fence(__ATOMIC_RELEASE, "agent");
            asm volatile("s_waitcnt vmcnt(0)" ::: "memory");
            const unsigned og = xb_add(&bar[XB_TOP], 1u);
            const unsigned tg = og / nx;
            if (og + 1u == (tg + 1u) * nx) xb_add(&bar[XB_TOPGEN], 1u);
            else XB_SPIN(xb_ld(&bar[XB_TOPGEN]) == tg, bar);
            __builtin_amdgcn_fence(__ATOMIC_ACQUIRE, "agent");
            xb_add(&bar[XB_XGEN(b.x)], 1u);
            asm volatile("s_waitcnt vmcnt(0)" ::: "memory");
        } else {
            XB_SPIN(xb_ld(&bar[XB_XGEN(b.x)]) == gen, bar);
            __builtin_amdgcn_fence(__ATOMIC_ACQUIRE, "agent");
            asm volatile("s_waitcnt vmcnt(0)" ::: "memory");
        }
    }
    __syncthreads();
}

__device__ __forceinline__ f32x4 skinny_dot(const bf16_t* ap, const bf16_t* bp, int nks, f32x4 acc) {
#pragma unroll 8
    for (int ks = 0; ks < nks; ++ks) { const bf16x8 av = *(const bf16x8*)(ap + 32 * ks), bv = *(const bf16x8*)(bp + 32 * ks); acc = __builtin_amdgcn_mfma_f32_16x16x32_bf16(bv, av, acc, 0, 0, 0); }
    return acc;
}
__device__ __forceinline__ void skinny_resid(const bf16_t* A, int lda, const bf16_t* Bt, int ldb, int K, const float* baseS, float* outS, const float* gate, float coef, int bx, int G) {
    const int tid = threadIdx.x, w = __builtin_amdgcn_readfirstlane(tid >> 6), lane = tid & 63, il = lane & 15, kg = lane >> 4;
    for (int it = bx; it < 256; it += G) {
        const int cb = it >> 1, r = (it & 1) * 128 + 16 * w + il, col = 16 * cb + 4 * kg;
        const f32x4 acc = skinny_dot(A + (size_t)(MP + r) * lda + 8 * kg, Bt + (size_t)(16 * cb + il) * ldb + 8 * kg, K / 32, (f32x4){0.f, 0.f, 0.f, 0.f});
        const f32x4 gg = *(const f32x4*)(gate + (size_t)(4 + (r >> 5)) * MODW + col) * coef;
        *(f32x4*)(outS + (size_t)r * DM + col) = *(const f32x4*)(baseS + (size_t)r * DM + col) + gg * acc;
    }
}
__device__ __forceinline__ void skinny_merge(const bf16_t* AO, const bf16_t* WPAB, const bf16_t* GA, const bf16_t* GB, bf16_t* Y, int bx, int G) {
    const int tid = threadIdx.x, w = __builtin_amdgcn_readfirstlane(tid >> 6), lane = tid & 63, il = lane & 15, kg = lane >> 4;
    for (int it = bx; it < 256; it += G) {
        const int cb = it >> 1, r = (it & 1) * 128 + 16 * w + il, col = 16 * cb + 4 * kg;
        const bf16_t* ap = AO + (size_t)(MP + r) * 2048 + 8 * kg; const bf16_t* bp = WPAB + (size_t)(16 * cb + il) * 2048 + 8 * kg;
        const f32x4 a1 = skinny_dot(ap, bp, 32, (f32x4){0.f, 0.f, 0.f, 0.f}), a2 = skinny_dot(ap + 1024, bp + 1024, 32, (f32x4){0.f, 0.f, 0.f, 0.f});
        const size_t o = (size_t)(MP + r) * DM + col;
        const u32x2 ga = *(const u32x2*)(GA + o), gb = *(const u32x2*)(GB + o);
        const f32x4 sa = (f32x4){bf_lo(ga.x), bf_hi(ga.x), bf_lo(ga.y), bf_hi(ga.y)}, sb = (f32x4){bf_lo(gb.x), bf_hi(gb.x), bf_lo(gb.y), bf_hi(gb.y)};
        const f32x4 y = sa * a1 + sb * a2;
        u32x2 pk; pk.x = cvt_pk_bf16(y[0], y[1]); pk.y = cvt_pk_bf16(y[2], y[3]);
        *(u32x2*)(Y + o) = pk;
    }
}

__global__ void __launch_bounds__(NTHR, 2) fwd_kernel(Args a) {
    extern __shared__ __attribute__((aligned(16))) unsigned char lds_raw[];
    LAS unsigned char* lds = (LAS unsigned char*)lds_raw;
    const int tid = threadIdx.x, lane = tid & 63, wave = __builtin_amdgcn_readfirstlane(tid >> 6);
    const int G = gridDim.x, bx = blockIdx.x;
    const int gw = bx * NWAVES + wave, NGW = G * NWAVES;
    unsigned char* ws = a.ws; float* out = a.out;
    float* MOD = (float*)(ws + WS_MOD); f32x2* ROPE = (f32x2*)(ws + WS_ROPE); f32x2* STATS = (f32x2*)(ws + WS_STATS);
    bf16_t* W13 = (bf16_t*)(ws + WS_W13); bf16_t* W2 = (bf16_t*)(ws + WS_W2); bf16_t* WIN = (bf16_t*)(ws + WS_WIN); bf16_t* WPAB = (bf16_t*)(ws + WS_WPAB); bf16_t* WO = (bf16_t*)(ws + WS_WO);
    float* X1 = (float*)(ws + WS_X1); bf16_t* H = (bf16_t*)(ws + WS_H); bf16_t* Gb = (bf16_t*)(ws + WS_G);
    const int lo = a.ph_lo, hi = a.ph_hi;
    volatile LAS unsigned* MISC = (volatile LAS unsigned*)(lds + LDS_BYTES - 64);
    if (tid < 16) MISC[tid] = 0u;
    __syncthreads();
    XcdBarrier bar; bar.bar = (unsigned*)ws; bar.x = 0; bar.st = nullptr;
    if (hi - lo > 1) bar = xcd_barrier_post((unsigned*)ws, MISC);
#define IN(k) (lo <= (k) && (k) < hi)
#define SEAM(k) do { if (IN(k) && IN((k) + 1)) { if ((k) == 0) cg::this_grid().sync(); else xcd_barrier(bar); } } while (0)

    if (IN(0)) {
        {
            const float invf[8] = {1.0f, 0.1939227432012558f, 0.03760603070259094f, 0.007292664609849453f, 0.0014142135623842478f, 0.00027424818836152554f, 5.318296098266728e-05f, 1.0313386155758053e-05f};
            for (int i = bx * NTHR + tid; i < SEQ * 8; i += G * NTHR) {
                const int pos = i >> 3, f = i & 7;
                float fv = invf[0];
#pragma unroll
                for (int q = 1; q < 8; ++q) fv = (f == q) ? invf[q] : fv;
                const float ang = (float)pos * fv;
                const double ad = (double)ang; const double n = __builtin_rint(ad * 0.15915494309189535); const float rr = (float)(ad - n * 6.283185307179586);
                ROPE[i] = (f32x2){cosf(rr), sinf(rr)};
            }
            for (int i = bx * NTHR + tid; i < 8 * 24576 / 4; i += G * NTHR) {
                const int b = i / 6144, o = (i - b * 6144) * 4;
                *(f32x4*)(out + O_KS + (size_t)b * 32768 + o) = *(const f32x4*)(a.in[2] + (size_t)b * 32768 + 8192 + o);
                *(f32x4*)(out + O_VS + (size_t)b * 32768 + o) = *(const f32x4*)(a.in[3] + (size_t)b * 32768 + 8192 + o);
            }
        }
        {
            LAS float* sl = (LAS float*)lds;
            LAS float* red = (LAS float*)(lds + 98304);
            for (int idx = tid; idx < 12 * 2048; idx += NTHR) { const int r = idx >> 11, k = idx & 2047; const float c = r < 4 ? a.in[4][r * 2048 + k] : a.in[5][(r - 4) * 2048 + k]; sl[k * 12 + r] = c * sigmoidf_(c); }
            __syncthreads();
            for (int cb = bx; cb < MODW / 64; cb += G) {
                float acc[12];
#pragma unroll
                for (int r = 0; r < 12; ++r) acc[r] = 0.f;
                const float* wp = a.in[6] + (size_t)(wave * 256) * MODW + cb * 64 + lane;
#pragma unroll 8
                for (int k = 0; k < 256; ++k) {
                    const float wv = wp[(size_t)k * MODW];
                    const LAS f32x4* sp = (const LAS f32x4*)(sl + (wave * 256 + k) * 12);
                    const f32x4 s0 = sp[0], s1 = sp[1], s2 = sp[2];
                    acc[0] += s0[0] * wv; acc[1] += s0[1] * wv; acc[2] += s0[2] * wv; acc[3] += s0[3] * wv;
                    acc[4] += s1[0] * wv; acc[5] += s1[1] * wv; acc[6] += s1[2] * wv; acc[7] += s1[3] * wv;
                    acc[8] += s2[0] * wv; acc[9] += s2[1] * wv; acc[10] += s2[2] * wv; acc[11] += s2[3] * wv;
                }
#pragma unroll
                for (int r = 0; r < 12; ++r) red[(wave * 12 + r) * 64 + lane] = acc[r];
                __syncthreads();
                for (int o = tid; o < 768; o += NTHR) { const int r = o >> 6, cl = o & 63; float s = a.in[7][cb * 64 + cl];
#pragma unroll
                    for (int q = 0; q < 8; ++q) s += red[(q * 12 + r) * 64 + cl];
                    MOD[(size_t)r * MODW + cb * 64 + cl] = s; }
                __syncthreads();
            }
        }
        __syncthreads();
        {
            LAS float* scr = (LAS float*)(lds + wave * 8448);
            transpose_ffn(a.in[9], a.in[10], a.in[11], ws, scr, gw, NGW, lane);
            for (int it = gw; it < IT_WIN + 2 * IT_WP + IT_WO; it += NGW) {
                int r = it;
                if (r < IT_WIN) { tr_mat(r, a.in[13], DM, DIN, WIN, DM, 0, 3, scr, lane); continue; } r -= IT_WIN;
                if (r < IT_WP) { tr_mat(r, a.in[21], DA, DM, WPAB, 2048, 0, 0, scr, lane); continue; } r -= IT_WP;
                if (r < IT_WP) { tr_mat(r, a.in[22], DB, DM, WPAB, 2048, 1024, 0, scr, lane); continue; } r -= IT_WP;
                tr_mat(r, a.in[23], DM, DM, WO, DM, 0, 0, scr, lane);
            }
        }
    }
    SEAM(0);
    if (IN(1)) norm_phase(a.in[0], a.in[1], a.in[8], MOD, 0, H, gw, NGW, lane);
    SEAM(1);
    if (IN(2)) { pg8::Gemm g{H, W13, MT, 2 * DFF, DM, DM, DM}; pg8::StaticOrder S; S.init(MT, 2 * DFF, G, bx); EpiSwiGLU E{Gb}; pg8::gemm_phase(lds, g, S, E); }
    SEAM(2);
    if (IN(3)) { skinny_resid(Gb, DFF, W2, DFF, DFF, a.in[1], X1 + (size_t)MP * DM, MOD + 0 * 3 * DM + 2 * DM, 0.5f, bx, G);
        pg8::Gemm g{Gb, W2, MP, DM, DFF, DFF, DFF}; pg8::StaticOrder S; S.init(MP, DM, G, bx); EpiResid E{a.in[0], a.in[1], X1, MOD + 0 * 3 * DM + 2 * DM, 0.5f}; pg8::gemm_phase(lds, g, S, E); }
    SEAM(3);
    if (IN(4)) {
        norm_phase(X1, X1 + (size_t)MP * DM, a.in[12], MOD, 1, H, gw, NGW, lane);
        transpose_ffn(a.in[25], a.in[26], a.in[27], ws, (LAS float*)(lds + wave * 8448), gw, NGW, lane);
    }
    SEAM(4);
    if (IN(5)) { pg8::Gemm g{H, WIN, MT, DIN, DM, DM, DM}; pg8::StaticOrder S; S.init(MT, DIN, G, bx);
        EpiWin E{ws, STATS, a.in[14], a.in[15], ROPE, out};
        pg8::gemm_phase(lds, g, S, E); }
    SEAM(5);
    if (IN(6)) {
        for (int it = bx; it < 4192; it += G) {
            if (it < 2048) attn_unit(lds, a, it >> 9, (it >> 2) & 127, it & 3, -1);
            else if (it < 4096) spatial_unit(lds, a, ((it - 2048) >> 3) * 128, 128, it & 7, -1);
            else if (it < 4128) attn_unit(lds, a, 0, 0, it & 3, (it - 4096) >> 2);
            else spatial_unit(lds, a, MP + ((it - 4128) >> 3) * 32, 32, it & 7, (it - 4128) >> 3);
        }
        __syncthreads();
    }
    SEAM(6);
    if (IN(7)) {
        bf16_t* AO = (bf16_t*)(ws + WS_AO); bf16_t* Y = (bf16_t*)(ws + WS_Y); float* T = out + O_Y;
        skinny_merge(AO, WPAB, (const bf16_t*)(ws + WS_GA), (const bf16_t*)(ws + WS_GB), Y, bx, G);
        { pg8::Gemm g{AO, WPAB, MP, DM, DA, 2048, 2048}; pg8::StaticOrder S; S.init(MP, DM, G, bx); EpiMerge1 E{(const bf16_t*)(ws + WS_GA), T}; pg8::gemm_phase(lds, g, S, E); }
        { pg8::Gemm g{AO + 1024, WPAB + 1024, MP, DM, DB, 2048, 2048}; pg8::StaticOrder S; S.init(MP, DM, G, bx); EpiMerge2 E{(const bf16_t*)(ws + WS_GB), T, Y}; pg8::gemm_phase(lds, g, S, E); }
    }
    SEAM(7);
    if (IN(8)) { skinny_resid((bf16_t*)(ws + WS_Y), DM, WO, DM, DM, X1 + (size_t)MP * DM, out + O_Y + (size_t)MP * DM, MOD + 1 * 3 * DM + 2 * DM, 1.0f, bx, G);
        pg8::Gemm g{(bf16_t*)(ws + WS_Y), WO, MP, DM, DM, DM, DM}; pg8::StaticOrder S; S.init(MP, DM, G, bx); EpiResid E{X1, X1 + (size_t)MP * DM, out + O_Y, MOD + 1 * 3 * DM + 2 * DM, 1.0f}; pg8::gemm_phase(lds, g, S, E); }
    SEAM(8);
    if (IN(9)) norm_phase(out + O_Y, out + O_Y + (size_t)MP * DM, a.in[24], MOD, 2, H, gw, NGW, lane);
    SEAM(9);
    if (IN(10)) { pg8::Gemm g{H, W13, MT, 2 * DFF, DM, DM, DM}; pg8::StaticOrder S; S.init(MT, 2 * DFF, G, bx); EpiSwiGLU E{Gb}; pg8::gemm_phase(lds, g, S, E); }
    SEAM(10);
    if (IN(11)) { skinny_resid(Gb, DFF, W2, DFF, DFF, out + O_Y + (size_t)MP * DM, out + O_Y + (size_t)MP * DM, MOD + 2 * 3 * DM + 2 * DM, 0.5f, bx, G);
        pg8::Gemm g{Gb, W2, MP, DM, DFF, DFF, DFF}; pg8::StaticOrder S; S.init(MP, DM, G, bx); EpiResid E{out + O_Y, out + O_Y + (size_t)MP * DM, out + O_Y, MOD + 2 * 3 * DM + 2 * DM, 0.5f}; pg8::gemm_phase(lds, g, S, E); }
#undef IN
#undef SEAM
}

extern "C" void kernel_launch(void* const* d_in, const int* in_sizes, int n_in, void* d_out, int out_size, void* d_ws, size_t ws_size, hipStream_t stream) {
    static int grid = 0;
    if (grid == 0) {
        if (n_in != 28 || (size_t)out_size != O_END || ws_size < 1024 * MiB) { fprintf(stderr, "kernel_launch: unexpected shapes: n_in %d out %d ws %zu\n", n_in, out_size, ws_size); grid = -1; return; }
        int dev = 0, cus = 0, per_cu = 0;
        if (hipGetDevice(&dev) != hipSuccess || hipDeviceGetAttribute(&cus, hipDeviceAttributeMultiprocessorCount, dev) != hipSuccess) { grid = -1; return; }
        if (hipFuncSetAttribute((const void*)fwd_kernel, hipFuncAttributeMaxDynamicSharedMemorySize, LDS_BYTES) != hipSuccess) { fprintf(stderr, "kernel_launch: hipFuncSetAttribute failed\n"); grid = -1; return; }
        if (hipOccupancyMaxActiveBlocksPerMultiprocessor(&per_cu, (const void*)fwd_kernel, NTHR, LDS_BYTES) != hipSuccess || per_cu < 1) { fprintf(stderr, "kernel_launch: occupancy query says %d\n", per_cu); per_cu = 1; }
        (void)hipGetLastError();
        grid = cus * 1;
        fprintf(stderr, "kernel_launch: grid %d (cus %d, per_cu %d)\n", grid, cus, per_cu);
    }
    if (grid < 0) return;
    if (hipMemsetAsync(d_ws, 0, 65536, stream) != hipSuccess) { fprintf(stderr, "kernel_launch: memset failed\n"); return; }
    Args a{};
    for (int i = 0; i < 28; ++i) a.in[i] = (const float*)d_in[i];
    a.out = (float*)d_out; a.ws = (unsigned char*)d_ws;
#if MK_N_LAUNCHES == 1
    a.ph_lo = 0; a.ph_hi = 12;
    void* args[] = {&a};
    hipError_t e = hipLaunchCooperativeKernel((const void*)fwd_kernel, dim3(grid), dim3(NTHR), args, LDS_BYTES, stream);
    if (e != hipSuccess) fprintf(stderr, "kernel_launch: cooperative launch failed: %s (grid %d)\n", hipGetErrorString(e), grid);
#else
    for (int p = 0; p < 12; ++p) { a.ph_lo = p; a.ph_hi = p + 1; hipLaunchKernelGGL(fwd_kernel, dim3(grid), dim3(NTHR), LDS_BYTES, stream, a); }
#endif
}
```

```cpp
#include <hip/hip_runtime.h>
#include <hip/hip_cooperative_groups.h>
#include <cstdio>
#include <cstdint>
namespace cg = cooperative_groups;

#ifndef MK_N_LAUNCHES
#define MK_N_LAUNCHES 1
#endif
#ifndef REPMASK
#define REPMASK 0
#endif
#define REPS(k) for (int rep_ = 0; rep_ <= ((REPMASK >> (k)) & 1); ++rep_)

namespace pg8 {
#define PG8_LAS __attribute__((address_space(3)))
typedef unsigned short bf16_t;
typedef short bf16x8 __attribute__((ext_vector_type(8)));
typedef float f32x4 __attribute__((ext_vector_type(4)));
typedef float f32x2 __attribute__((ext_vector_type(2)));
typedef unsigned u32x4 __attribute__((ext_vector_type(4)));
typedef unsigned u32x2 __attribute__((ext_vector_type(2)));
constexpr int BM = 256, BK = 64, HALF = 128, HTB = HALF * BK * 2, STAGE_BYTES = 8 * HTB, NXCD = 8, WGM = 8;

__host__ __device__ __forceinline__ int lds_byte(int r, int c) { const int st = (r >> 4) * 2 + (c >> 5), rr = r & 15, cc = c & 31, ob = rr * 64 + cc * 2; return st * 1024 + (ob ^ (((ob >> 9) & 1) << 5)); }
__host__ __device__ __forceinline__ void stage_rc(int b, int& R, int& C) { const int st = b / 1024, sb = b % 1024, swz = sb ^ (((sb >> 9) & 1) << 5); R = (st >> 1) * 16 + swz / 64; C = (st & 1) * 32 + (swz % 64) / 2; }
__host__ __device__ __forceinline__ int perm32(int rho) { const int n = rho >> 4, i = rho & 15; return 8 * (i >> 2) + 4 * n + (i & 3); }

struct Unit { int pm, pn; };
struct Gemm { const bf16_t* A; const bf16_t* Bt; int M, N, K, lda, ldb; size_t kstepA, kstepB; };

struct StaticOrder {
    int nM, nN, nwg, G, c, wgm;
    __host__ __device__ void init(int M, int N, int G_, int c_, int wgm_ = WGM) { nM = M / BM; nN = N / BM; nwg = nM * nN; G = G_; c = c_; wgm = wgm_; }
    __host__ __device__ bool next(int i, Unit& u) const {
        const long L = (long)i * G + c; if (L >= nwg) return false;
        int wgid = (int)L; { const int q = nwg / NXCD, r = nwg % NXCD, xcd = wgid % NXCD, off = wgid / NXCD; wgid = (xcd < r ? xcd * (q + 1) : r * (q + 1) + (xcd - r) * q) + off; }
        const int nig = wgm * nN, gid = wgid / nig, fm = gid * wgm, gsz = (nM - fm) < wgm ? (nM - fm) : wgm;
        u.pm = fm + ((wgid % nig) % gsz); u.pn = (wgid % nig) / gsz; return true;
    }
};

__device__ __forceinline__ unsigned cvt_pk_bf16(float lo, float hi) { unsigned r; asm volatile("v_cvt_pk_bf16_f32 %0, %1, %2" : "=v"(r) : "v"(lo), "v"(hi)); return r; }
__device__ __forceinline__ f32x2 gelu_pk(f32x2 v) {
    const f32x2 av = __builtin_elementwise_abs(v), d = av * 0.2316418882f + 1.0f;
    f32x2 t; t.x = __builtin_amdgcn_rcpf(d.x); t.y = __builtin_amdgcn_rcpf(d.y);
    f32x2 q = t * 0.5307027145f + (-0.7265760135f); q = q * t + 0.7107068705f; q = q * t + (-0.142248368f); q = q * t + 0.127414796f; q = q * t;
    const f32x2 s = (v * v) * (-0.72134752044f);
    f32x2 e; e.x = __builtin_amdgcn_exp2f(s.x); e.y = __builtin_amdgcn_exp2f(s.y);
    const f32x2 m = v * (q * e), r = v - m;
    f32x2 o; o.x = v.x < 0.f ? m.x : r.x; o.y = v.y < 0.f ? m.y : r.y; return o;
}
__device__ __forceinline__ f32x4 gelu4(f32x4 v) { const f32x2 a = gelu_pk((f32x2){v[0], v[1]}), b = gelu_pk((f32x2){v[2], v[3]}); return (f32x4){a.x, a.y, b.x, b.y}; }

template <class Epi, class Sched>
__device__ __forceinline__ void gemm_phase(PG8_LAS unsigned char* lds, const Gemm g, const Sched& S, const Epi& E) {
    const int tid = threadIdx.x, wid = __builtin_amdgcn_readfirstlane(tid >> 6), lane = tid & 63, wr = wid >> 2, wc = wid & 3, fr = lane & 15, fq = lane >> 4;
    const int K = g.K, nt = K / BK;
    unsigned voffA[2], voffB[2];
#pragma unroll
    for (int i = 0; i < 2; ++i) { int R, C; stage_rc(tid * 16 + i * 8192, R, C); const int Rb = Epi::PERM ? ((R & ~31) + perm32(R & 31)) : R;
        voffA[i] = (unsigned)(R * g.lda + C) * 2u; voffB[i] = (unsigned)(Rb * g.ldb + C) * 2u; }
    const size_t kstepA = g.kstepA, kstepB = g.kstepB;
    const size_t hstepA = (size_t)HALF * g.lda * 2, hstepB = (size_t)HALF * g.ldb * 2;
    const size_t tstepA = 2 * hstepA, tstepB = 2 * hstepB;
    const unsigned ldsw = (unsigned)wid * 1024u;
    const int aoff = lds_byte(wr * 64 + fr, fq * 8), boff = lds_byte(wc * 32 + fr, fq * 8);
#define PG8_SA(b, h) (((b) * 2 + (h)) * HTB)
#define PG8_SB(b, h) ((4 + (b) * 2 + (h)) * HTB)
#define PG8_STAGE(bufoff, gbase, voff) do { _Pragma("unroll") for (int _i = 0; _i < 2; ++_i) \
        __builtin_amdgcn_global_load_lds((const unsigned*)((const char*)(gbase) + (voff)[_i]), (PG8_LAS unsigned*)(lds + (bufoff) + ldsw + _i * 8192), 16, 0, 0); } while (0)
#define PG8_LDA(dst, b, h) do { _Pragma("unroll") for (int m = 0; m < 4; ++m) _Pragma("unroll") for (int k = 0; k < 2; ++k) dst[m][k] = *(const PG8_LAS bf16x8*)(lds + PG8_SA(b, h) + aoff + m * 2048 + k * 1024); } while (0)
#define PG8_LDB(dst, b, h) do { _Pragma("unroll") for (int n = 0; n < 2; ++n) _Pragma("unroll") for (int k = 0; k < 2; ++k) dst[n][k] = *(const PG8_LAS bf16x8*)(lds + PG8_SB(b, h) + boff + n * 2048 + k * 1024); } while (0)
#define PG8_MMA(ai, bj, At, Bt) do { __builtin_amdgcn_s_setprio(1); _Pragma("unroll") for (int m = 0; m < 4; ++m) _Pragma("unroll") for (int n = 0; n < 2; ++n) _Pragma("unroll") for (int k = 0; k < 2; ++k) \
        acc[ai][bj][m][n] = __builtin_amdgcn_mfma_f32_16x16x32_bf16(Bt[n][k], At[m][k], acc[ai][bj][m][n], 0, 0, 0); __builtin_amdgcn_s_setprio(0); } while (0)
#define PG8_WAIT_V(n) asm volatile("s_waitcnt vmcnt(" #n ")" ::: "memory")
#define PG8_WAIT_L(n) asm volatile("s_waitcnt lgkmcnt(" #n ")" ::: "memory")
#define PG8_BAR __builtin_amdgcn_s_barrier()
#define PG8_SCHED __builtin_amdgcn_sched_barrier(0)
    Unit cur, nxt; int ui = 0;
    if (!S.next(0, cur)) return;
    f32x4 acc[2][2][4][2];
#pragma unroll
    for (int a = 0; a < 2; ++a)
#pragma unroll
        for (int b = 0; b < 2; ++b)
#pragma unroll
            for (int m = 0; m < 4; ++m)
#pragma unroll
                for (int n = 0; n < 2; ++n) acc[a][b][m][n] = (f32x4){0.f, 0.f, 0.f, 0.f};
    bf16x8 At[4][2], B0[2][2], B1[2][2];
    const char* cA = (const char*)g.A + (size_t)cur.pm * tstepA; const char* cB = (const char*)g.Bt + (size_t)cur.pn * tstepB;
    PG8_STAGE(PG8_SB(0, 0), cB, voffB); PG8_STAGE(PG8_SB(0, 1), cB + hstepB, voffB); PG8_STAGE(PG8_SA(0, 0), cA, voffA); PG8_STAGE(PG8_SA(0, 1), cA + hstepA, voffA);
    if (wr == 1) PG8_BAR;
    PG8_WAIT_V(2); PG8_BAR;
    PG8_STAGE(PG8_SB(1, 0), cB + kstepB, voffB); PG8_STAGE(PG8_SA(1, 0), cA + kstepA, voffA); PG8_STAGE(PG8_SB(1, 1), cB + hstepB + kstepB, voffB);
    PG8_WAIT_V(6); PG8_BAR;
    for (;;) {
        const bool has_next = S.next(ui + 1, nxt);
        const char* nA = has_next ? (const char*)g.A + (size_t)nxt.pm * tstepA : cA; const char* nB = has_next ? (const char*)g.Bt + (size_t)nxt.pn * tstepB : cB;
        for (int t = 0; t < nt; t += 2) {
            if constexpr (Epi::HAS_MID) { if (t == Epi::MID_T) E.mid(acc, cur, wr, wc, fr, fq); }
            const bool last = (t == nt - 2);
            const char* a1 = cA + (size_t)(t + 1) * kstepA;
            const char* a2 = last ? nA : cA + (size_t)(t + 2) * kstepA; const char* b2 = last ? nB : cB + (size_t)(t + 2) * kstepB;
            const char* a3 = a2 + kstepA; const char* b3 = b2 + kstepB;
            PG8_LDB(B0, 0, 0); PG8_LDB(B1, 0, 1); PG8_SCHED; PG8_LDA(At, 0, 0); PG8_STAGE(PG8_SA(1, 1), a1 + hstepA, voffA);
            PG8_WAIT_V(8); PG8_WAIT_L(0); PG8_BAR; PG8_MMA(0, 0, At, B0); PG8_MMA(0, 1, At, B1); PG8_BAR; PG8_SCHED;
            PG8_LDA(At, 0, 1); PG8_STAGE(PG8_SB(0, 0), b2, voffB); PG8_STAGE(PG8_SB(0, 1), b2 + hstepB, voffB); PG8_STAGE(PG8_SA(0, 0), a2, voffA);
            PG8_WAIT_V(8); PG8_WAIT_L(0); PG8_BAR; PG8_MMA(1, 0, At, B0); PG8_MMA(1, 1, At, B1); PG8_BAR; PG8_SCHED;
            PG8_LDB(B0, 1, 0); PG8_LDB(B1, 1, 1); PG8_SCHED; PG8_LDA(At, 1, 0); PG8_STAGE(PG8_SA(0, 1), a2 + hstepA, voffA);
            PG8_WAIT_V(8); PG8_WAIT_L(0); PG8_BAR; PG8_MMA(0, 0, At, B0); PG8_MMA(0, 1, At, B1); PG8_BAR; PG8_SCHED;
            PG8_LDA(At, 1, 1); PG8_STAGE(PG8_SB(1, 0), b3, voffB); PG8_STAGE(PG8_SB(1, 1), b3 + hstepB, voffB); PG8_STAGE(PG8_SA(1, 0), a3, voffA);
            PG8_WAIT_V(8); PG8_WAIT_L(0); PG8_BAR; PG8_MMA(1, 0, At, B0); PG8_MMA(1, 1, At, B1); PG8_BAR; PG8_SCHED;
        }
        if (wr == 0) PG8_BAR;
        E(acc, cur, wr, wc, fr, fq);
        if (!has_next) break;
#pragma unroll
        for (int a = 0; a < 2; ++a)
#pragma unroll
            for (int b = 0; b < 2; ++b)
#pragma unroll
                for (int m = 0; m < 4; ++m)
#pragma unroll
                    for (int n = 0; n < 2; ++n) acc[a][b][m][n] = (f32x4){0.f, 0.f, 0.f, 0.f};
        cur = nxt; cA = nA; cB = nB; ++ui;
        if (wr == 1) PG8_BAR;
    }
    PG8_WAIT_V(0);
    PG8_BAR;
#undef PG8_SA
#undef PG8_SB
#undef PG8_STAGE
#undef PG8_LDA
#undef PG8_LDB
#undef PG8_MMA
#undef PG8_WAIT_V
#undef PG8_WAIT_L
#undef PG8_BAR
#undef PG8_SCHED
}
}

using pg8::bf16_t; using pg8::bf16x8; using pg8::f32x4; using pg8::f32x2; using pg8::u32x4; using pg8::u32x2; using pg8::cvt_pk_bf16; using pg8::Unit;
#define LAS __attribute__((address_space(3)))

constexpr int DM = 2048, DFF = 5632, DA = 1024, DB = 1024, DKV = 256, DIN = 7680;
constexpr int MP = 32768, MS = 256, MT = MP + MS, SEQ = 8192;
constexpr int MODW = 18432;
constexpr float EPS = 1e-6f;
constexpr int NWAVES = 8, NTHR = 512;
constexpr int LDS_BYTES = 147456;

constexpr size_t O_Y = 0, O_KP = (size_t)MT * DM, O_VP = O_KP + 131072, O_KS = O_VP + 131072, O_VS = O_KS + 262144, O_GV = O_VS + 262144, O_END = O_GV + 262144;

constexpr size_t MiB = 1u << 20;
constexpr size_t WS_MOD = 1 * MiB, WS_ROPE = 2 * MiB, WS_STATS = 3 * MiB;
constexpr size_t WS_W13 = 8 * MiB, WS_W2 = 52 * MiB, WS_WIN = 74 * MiB, WS_WPAB = 104 * MiB, WS_WO = 112 * MiB;
constexpr size_t WS_X1 = 120 * MiB, WS_H = 378 * MiB, WS_G = 507 * MiB;
constexpr size_t SZ_M1024 = (size_t)MT * 1024 * 2, SZ_M256 = (size_t)MT * 256 * 2, SZ_M2048 = (size_t)MT * 2048 * 2;
constexpr size_t WS_U = WS_G, WS_GV = WS_U + SZ_M1024, WS_Q = WS_GV + SZ_M1024, WS_K = WS_Q + SZ_M1024, WS_V = WS_K + SZ_M256, WS_GA = WS_V + SZ_M256, WS_GB = WS_GA + SZ_M2048, WS_END = WS_GB + SZ_M2048;
constexpr size_t WS_W2B = 992 * MiB;
static_assert(WS_END <= WS_W2B && WS_W2B + (size_t)DM * DFF * 2 <= 1024 * MiB, "W2B");
constexpr size_t WS_Y = WS_U;
constexpr size_t WS_AO = WS_H;
static_assert(WS_G + (size_t)MT * DFF * 2 <= 1024 * MiB && WS_END <= 1024 * MiB, "workspace map");
static_assert(WS_STATS + (size_t)MT * 16 * 8 <= WS_W13, "stats");

struct Args { const float* in[28]; float* out; unsigned char* ws; int ph_lo, ph_hi; };

__device__ __forceinline__ int mrow(int row) { return row < MP ? (row >> 13) : 4 + ((row - MP) >> 5); }
__device__ __forceinline__ float bf_lo(unsigned w) { return __uint_as_float(w << 16); }
__device__ __forceinline__ float bf_hi(unsigned w) { return __uint_as_float(w & 0xffff0000u); }
__device__ __forceinline__ float wave_sum(float v) {
#pragma unroll
    for (int o = 1; o < 64; o <<= 1) v += __shfl_xor(v, o);
    return v;
}
__device__ __forceinline__ float sigmoidf_(float x) { return __builtin_amdgcn_rcpf(1.0f + __expf(-x)); }

struct EpiSwiGLU {
    static constexpr bool PERM = true, HAS_MID = false; static constexpr int MID_T = 0;
    bf16_t* G;
    __device__ __forceinline__ void operator()(const f32x4 (&acc)[2][2][4][2], const Unit& u, int wr, int wc, int fr, int fq) const {
        const int row0 = u.pm * 256 + wr * 64 + fr, col = u.pn * 128 + wc * 32 + 8 * fq;
#pragma unroll
        for (int ai = 0; ai < 2; ++ai)
#pragma unroll
            for (int m = 0; m < 4; ++m) {
                const int row = row0 + ai * 128 + m * 16;
                f32x4 r[2];
#pragma unroll
                for (int n = 0; n < 2; ++n) { const f32x4 a = acc[ai][0][m][n], b = acc[ai][1][m][n];
#pragma unroll
                    for (int e = 0; e < 4; ++e) r[n][e] = a[e] * b[e] * sigmoidf_(a[e]); }
                u32x4 w; w.x = cvt_pk_bf16(r[0][0], r[0][1]); w.y = cvt_pk_bf16(r[0][2], r[0][3]); w.z = cvt_pk_bf16(r[1][0], r[1][1]); w.w = cvt_pk_bf16(r[1][2], r[1][3]);
                __builtin_nontemporal_store(w, (u32x4*)(G + ((size_t)(col >> 6) * MT + row) * 64 + (col & 63)));
            }
    }
};

template <bool BASE_BF16, bool OUT_BF16> struct EpiResid {
    static constexpr bool PERM = true, HAS_MID = false; static constexpr int MID_T = 0;
    const void* baseP; const void* baseS; void* out; const float* gate; float coef;
    __device__ __forceinline__ void operator()(const f32x4 (&acc)[2][2][4][2], const Unit& u, int wr, int wc, int fr, int fq) const {
        const int pm = u.pm;
        const int colb = u.pn * 256 + wc * 32 + 8 * fq;
        f32x4 gv[2][2];
#pragma unroll
        for (int bj = 0; bj < 2; ++bj)
#pragma unroll
            for (int n = 0; n < 2; ++n) gv[bj][n] = *(const f32x4*)(gate + (size_t)(pm >> 5) * MODW + colb + bj * 128 + n * 4) * coef;
#pragma unroll
        for (int ah = 0; ah < 4; ++ah) {
            const int ai = ah >> 1;
            f32x4 b[2][2][2];
#pragma unroll
            for (int mm = 0; mm < 2; ++mm) {
                const int row = pm * 256 + ai * 128 + wr * 64 + (2 * (ah & 1) + mm) * 16 + fr;
                if (BASE_BF16) {
                    const bf16_t* bp = (const bf16_t*)baseP + (size_t)row * DM + colb;
#pragma unroll
                    for (int bj = 0; bj < 2; ++bj) { const u32x4 w = __builtin_nontemporal_load((const u32x4*)(bp + bj * 128));
                        b[mm][bj][0] = (f32x4){bf_lo(w.x), bf_hi(w.x), bf_lo(w.y), bf_hi(w.y)}; b[mm][bj][1] = (f32x4){bf_lo(w.z), bf_hi(w.z), bf_lo(w.w), bf_hi(w.w)}; }
                } else {
                    const float* bp = (const float*)baseP + (size_t)row * DM + colb;
#pragma unroll
                    for (int bj = 0; bj < 2; ++bj)
#pragma unroll
                        for (int n = 0; n < 2; ++n) b[mm][bj][n] = __builtin_nontemporal_load((const f32x4*)(bp + bj * 128 + n * 4));
                }
            }
#pragma unroll
            for (int mm = 0; mm < 2; ++mm) {
                const int m = 2 * (ah & 1) + mm;
                const int row = pm * 256 + ai * 128 + wr * 64 + m * 16 + fr;
#pragma unroll
                for (int bj = 0; bj < 2; ++bj) {
                    f32x4 r[2];
#pragma unroll
                    for (int n = 0; n < 2; ++n) r[n] = b[mm][bj][n] + gv[bj][n] * acc[ai][bj][m][n];
                    if (OUT_BF16) { u32x4 w; w.x = cvt_pk_bf16(r[0][0], r[0][1]); w.y = cvt_pk_bf16(r[0][2], r[0][3]); w.z = cvt_pk_bf16(r[1][0], r[1][1]); w.w = cvt_pk_bf16(r[1][2], r[1][3]);
                        *(u32x4*)((bf16_t*)out + (size_t)row * DM + colb + bj * 128) = w; }
                    else { float* op = (float*)out + (size_t)row * DM + colb + bj * 128; __builtin_nontemporal_store(r[0], (f32x4*)op); __builtin_nontemporal_store(r[1], (f32x4*)(op + 4)); }
                }
            }
            asm volatile("" ::: "memory");
        }
    }
};

struct EpiMergeF {
    static constexpr bool PERM = true, HAS_MID = true; static constexpr int MID_T = 16;
    const bf16_t* GA; const bf16_t* GB; bf16_t* Y;
    __device__ __forceinline__ void mid(f32x4 (&acc)[2][2][4][2], const Unit& u, int wr, int wc, int fr, int fq) const {
        int rowv = u.pm * 256 + wr * 64 + fr, colv = u.pn * 256 + wc * 32 + 8 * fq;
        asm volatile("" : "+v"(rowv), "+v"(colv));
        const unsigned off0 = (unsigned)rowv * DM + (unsigned)colv;
#pragma unroll
        for (int ai = 0; ai < 2; ++ai) {
            u32x4 ga[4][2], gb[4][2];
#pragma unroll
            for (int m = 0; m < 4; ++m) { const unsigned ro = off0 + (unsigned)((ai * 128 + m * 16) * DM);
#pragma unroll
                for (int bj = 0; bj < 2; ++bj) { ga[m][bj] = __builtin_nontemporal_load((const u32x4*)(GA + ro + bj * 128)); gb[m][bj] = *(const u32x4*)(GB + ro + bj * 128); } }
#pragma unroll
            for (int m = 0; m < 4; ++m)
#pragma unroll
                for (int bj = 0; bj < 2; ++bj) { const u32x4 a = ga[m][bj], b = gb[m][bj];
                    const f32x4 a0 = (f32x4){bf_lo(a.x), bf_hi(a.x), bf_lo(a.y), bf_hi(a.y)}, a1 = (f32x4){bf_lo(a.z), bf_hi(a.z), bf_lo(a.w), bf_hi(a.w)};
                    f32x4 b0 = (f32x4){bf_lo(b.x), bf_hi(b.x), bf_lo(b.y), bf_hi(b.y)}, b1 = (f32x4){bf_lo(b.z), bf_hi(b.z), bf_lo(b.w), bf_hi(b.w)};
#pragma unroll
                    for (int e = 0; e < 4; ++e) { b0[e] = __builtin_amdgcn_rcpf(fmaxf(b0[e], 1e-30f)); b1[e] = __builtin_amdgcn_rcpf(fmaxf(b1[e], 1e-30f)); }
                    acc[ai][bj][m][0] *= a0 * b0; acc[ai][bj][m][1] *= a1 * b1; }
            asm volatile("" ::: "memory");
        }
    }
    __device__ __forceinline__ void operator()(const f32x4 (&acc)[2][2][4][2], const Unit& u, int wr, int wc, int fr, int fq) const {
        const int colb = u.pn * 256 + wc * 32 + 8 * fq;
#pragma unroll
        for (int ai = 0; ai < 2; ++ai) {
            u32x4 gb[4][2];
#pragma unroll
            for (int m = 0; m < 4; ++m) { const size_t ro = (size_t)(u.pm * 256 + ai * 128 + wr * 64 + m * 16 + fr) * DM + colb;
#pragma unroll
                for (int bj = 0; bj < 2; ++bj) gb[m][bj] = *(const u32x4*)(GB + ro + bj * 128); }
#pragma unroll
            for (int m = 0; m < 4; ++m) { const size_t ro = (size_t)(u.pm * 256 + ai * 128 + wr * 64 + m * 16 + fr) * DM + colb;
#pragma unroll
                for (int bj = 0; bj < 2; ++bj) { const u32x4 b = gb[m][bj];
                    const f32x4 r0 = acc[ai][bj][m][0] * (f32x4){bf_lo(b.x), bf_hi(b.x), bf_lo(b.y), bf_hi(b.y)}, r1 = acc[ai][bj][m][1] * (f32x4){bf_lo(b.z), bf_hi(b.z), bf_lo(b.w), bf_hi(b.w)};
                    u32x4 w; w.x = cvt_pk_bf16(r0[0], r0[1]); w.y = cvt_pk_bf16(r0[2], r0[3]); w.z = cvt_pk_bf16(r1[0], r1[1]); w.w = cvt_pk_bf16(r1[2], r1[3]);
                    *(u32x4*)(Y + ro + bj * 128) = w; } }
            asm volatile("" ::: "memory");
        }
    }
};

struct EpiWin {
    static constexpr bool PERM = true, HAS_MID = false; static constexpr int MID_T = 0;
    unsigned char* ws; f32x2* stats; const float* gq; const float* gk; const f32x2* rope; float* out;
    __device__ __forceinline__ void operator()(const f32x4 (&acc)[2][2][4][2], const Unit& u, int wr, int wc, int fr, int fq) const {
        const int pn = u.pn, row0 = u.pm * 256 + wr * 64 + fr, cw = wc * 32 + 8 * fq;
        if (pn < 8) {
            bf16_t* dst = (bf16_t*)(ws + WS_U + (pn < 4 ? (size_t)0 : SZ_M1024)) + (pn & 3) * 256 + cw;
#pragma unroll
            for (int ai = 0; ai < 2; ++ai)
#pragma unroll
                for (int m = 0; m < 4; ++m) {
                    const int row = row0 + ai * 128 + m * 16; float s1 = 0.f, s2 = 0.f;
#pragma unroll
                    for (int bj = 0; bj < 2; ++bj) {
                        const f32x4 v0 = pg8::gelu4(acc[ai][bj][m][0]), v1 = pg8::gelu4(acc[ai][bj][m][1]);
                        s1 += (v0[0] + v0[1]) + (v0[2] + v0[3]) + (v1[0] + v1[1]) + (v1[2] + v1[3]);
                        s2 += (v0[0] * v0[0] + v0[1] * v0[1]) + (v0[2] * v0[2] + v0[3] * v0[3]) + (v1[0] * v1[0] + v1[1] * v1[1]) + (v1[2] * v1[2] + v1[3] * v1[3]);
                        u32x4 w; w.x = cvt_pk_bf16(v0[0], v0[1]); w.y = cvt_pk_bf16(v0[2], v0[3]); w.z = cvt_pk_bf16(v1[0], v1[1]); w.w = cvt_pk_bf16(v1[2], v1[3]);
                        __builtin_nontemporal_store(w, (u32x4*)(dst + (size_t)row * 1024 + bj * 128));
                    }
                    if (pn >= 4) {
                        s1 += __shfl_xor(s1, 16); s1 += __shfl_xor(s1, 32); s2 += __shfl_xor(s2, 16); s2 += __shfl_xor(s2, 32);
                        if (fq == 0) stats[(size_t)row * 16 + (pn - 4) * 4 + wc] = (f32x2){s1, s2};
                    }
                }
        } else if (pn < 14) {
            const int t = pn - 8; const bool isq = t < 4, isk = t == 4, isv = t == 5;
            const float* gvec = isq ? gq : gk;
            f32x4 gg[2][2];
#pragma unroll
            for (int bj = 0; bj < 2; ++bj)
#pragma unroll
                for (int n = 0; n < 2; ++n) gg[bj][n] = *(const f32x4*)(gvec + 32 * bj + 8 * fq + 4 * n);
#pragma unroll
            for (int ai = 0; ai < 2; ++ai)
#pragma unroll
                for (int m = 0; m < 4; ++m) {
                    const int row = row0 + ai * 128 + m * 16;
                    f32x4 x[2][2];
#pragma unroll
                    for (int bj = 0; bj < 2; ++bj)
#pragma unroll
                        for (int n = 0; n < 2; ++n) x[bj][n] = acc[ai][bj][m][n];
                    if (!isv) {
                        float ss = 0.f;
#pragma unroll
                        for (int bj = 0; bj < 2; ++bj)
#pragma unroll
                            for (int n = 0; n < 2; ++n) ss += (x[bj][n][0] * x[bj][n][0] + x[bj][n][1] * x[bj][n][1]) + (x[bj][n][2] * x[bj][n][2] + x[bj][n][3] * x[bj][n][3]);
                        ss += __shfl_xor(ss, 16); ss += __shfl_xor(ss, 32);
                        const float rstd = rsqrtf(ss * (1.0f / 64.0f) + EPS);
#pragma unroll
                        for (int bj = 0; bj < 2; ++bj)
#pragma unroll
                            for (int n = 0; n < 2; ++n) x[bj][n] = x[bj][n] * rstd * gg[bj][n];
                        const int pos = row < MP ? (row & (SEQ - 1)) : 2048 + ((row - MP) & 31);
                        f32x4 pr[2];
#pragma unroll
                        for (int n = 0; n < 2; ++n)
#pragma unroll
                            for (int e = 0; e < 4; ++e) pr[n][e] = __shfl_xor(x[0][n][e], 16);
                        if (fq < 2) {
                            const float sgn = fq == 0 ? -1.0f : 1.0f;
#pragma unroll
                            for (int n = 0; n < 2; ++n) {
                                const f32x4 c01 = *(const f32x4*)(rope + (size_t)pos * 8 + 4 * n), c23 = *(const f32x4*)(rope + (size_t)pos * 8 + 4 * n + 2);
                                x[0][n][0] = x[0][n][0] * c01[0] + sgn * pr[n][0] * c01[1];
                                x[0][n][1] = x[0][n][1] * c01[2] + sgn * pr[n][1] * c01[3];
                                x[0][n][2] = x[0][n][2] * c23[0] + sgn * pr[n][2] * c23[1];
                                x[0][n][3] = x[0][n][3] * c23[2] + sgn * pr[n][3] * c23[3];
                            }
                        }
                    }
                    bf16_t* dst = isq ? (bf16_t*)(ws + WS_Q) + (size_t)row * 1024 + (4 * t + wc) * 64 : (bf16_t*)(ws + WS_K + (isk ? (size_t)0 : SZ_M256)) + (size_t)row * 256 + wc * 64;
#pragma unroll
                    for (int bj = 0; bj < 2; ++bj) {
                        u32x4 w; w.x = cvt_pk_bf16(x[bj][0][0], x[bj][0][1]); w.y = cvt_pk_bf16(x[bj][0][2], x[bj][0][3]); w.z = cvt_pk_bf16(x[bj][1][0], x[bj][1][1]); w.w = cvt_pk_bf16(x[bj][1][2], x[bj][1][3]);
                        *(u32x4*)(dst + 32 * bj + 8 * fq) = w;
                    }
                    if (!isq) {
                        float* o = nullptr;
                        if (row < MP) { const int tp = row & (SEQ - 1); if (tp >= SEQ - 128) o = out + (isk ? O_KP : O_VP) + ((size_t)((row >> 13) * 128 + tp - (SEQ - 128)) * 4 + wc) * 64; }
                        else { const int j = (row - MP) & 31, b = (row - MP) >> 5; o = out + (isk ? O_KS : O_VS) + ((size_t)(b * 128 + 96 + j) * 4 + wc) * 64; }
                        if (o) {
#pragma unroll
                            for (int bj = 0; bj < 2; ++bj)
#pragma unroll
                                for (int n = 0; n < 2; ++n) *(f32x4*)(o + 32 * bj + 8 * fq + 4 * n) = x[bj][n];
                        }
                    }
                }
        } else {
            bf16_t* dst = (bf16_t*)(ws + WS_GA + (pn < 22 ? (size_t)0 : SZ_M2048)) + ((pn - 14) & 7) * 256 + cw;
#pragma unroll
            for (int ai = 0; ai < 2; ++ai)
#pragma unroll
                for (int m = 0; m < 4; ++m) {
                    const int row = row0 + ai * 128 + m * 16;
#pragma unroll
                    for (int bj = 0; bj < 2; ++bj) {
                        f32x4 v0 = acc[ai][bj][m][0], v1 = acc[ai][bj][m][1];
#pragma unroll
                        for (int e = 0; e < 4; ++e) { v0[e] = sigmoidf_(v0[e]); v1[e] = sigmoidf_(v1[e]); }
                        u32x4 w; w.x = cvt_pk_bf16(v0[0], v0[1]); w.y = cvt_pk_bf16(v0[2], v0[3]); w.z = cvt_pk_bf16(v1[0], v1[1]); w.w = cvt_pk_bf16(v1[2], v1[3]);
                        __builtin_nontemporal_store(w, (u32x4*)(dst + (size_t)row * 2048 + bj * 128));
                    }
                }
        }
    }
};

__device__ __forceinline__ void transpose_item(const float* W, int N, int k0, int n0, bf16_t* dst  , int ld, LAS float* scr, int lane) {
#pragma unroll 8
    for (int i = 0; i < 32; ++i) { const int kk = 2 * i + (lane >> 5); scr[kk * 33 + (lane & 31)] = __builtin_nontemporal_load(W + (size_t)(k0 + kk) * N + n0 + (lane & 31)); }
    asm volatile("s_waitcnt lgkmcnt(0)" ::: "memory");
    const int c = lane & 7;
#pragma unroll
    for (int j = 0; j < 4; ++j) { const int n = (lane >> 3) + 8 * j; const LAS float* s = scr + (8 * c) * 33 + n;
        u32x4 o; o.x = cvt_pk_bf16(s[0 * 33], s[1 * 33]); o.y = cvt_pk_bf16(s[2 * 33], s[3 * 33]); o.z = cvt_pk_bf16(s[4 * 33], s[5 * 33]); o.w = cvt_pk_bf16(s[6 * 33], s[7 * 33]);
        *(u32x4*)(dst + (size_t)n * ld + 8 * c) = o; }
    asm volatile("s_waitcnt lgkmcnt(0)" ::: "memory");
}
__device__ __forceinline__ void tr_mat(int r, const float* W, int K, int N, bf16_t* dst, int ld, int coff, int kind, LAS float* scr, int lane) {
    const int nblk = N / 32, kb = r / nblk, nb = r - kb * nblk, k0 = 64 * kb, n0 = 32 * nb;
    int drow = n0;
    if (kind == 1) drow = 256 * (n0 >> 7) + (n0 & 127);
    else if (kind == 2) drow = 256 * (n0 >> 7) + 128 + (n0 & 127);
    else if (kind == 3) { if (n0 >= 2048 && n0 < 3584) { const int t = n0 - 2048, tile = t >> 8, o = t & 255; drow = 2048 + 256 * tile + 128 * ((o >> 5) & 1) + 32 * (o >> 6); } }
    transpose_item(W, N, k0, n0, dst + (size_t)drow * ld + coff + k0, ld, scr, lane);
}
constexpr int W13_SPLIT = (2 * (DM / 64) * (DFF / 32)) * 3 / 5;
constexpr int IT_FFN13 = (DM / 64) * (DFF / 32), IT_FFN2 = (DFF / 64) * (DM / 32), IT_WIN = (DM / 64) * (DIN / 32), IT_WP = (DA / 64) * (DM / 32), IT_WO = (DM / 64) * (DM / 32);
__device__ __forceinline__ void transpose_w13(const float* w1, const float* w3, bf16_t* dst, LAS float* scr, int gw, int NGW, int lane, int lo = 0, int hi = 2 * IT_FFN13) {
    for (int it = lo + gw; it < hi; it += NGW) {
        if (it < IT_FFN13) tr_mat(it, w1, DM, DFF, dst, DM, 0, 1, scr, lane);
        else tr_mat(it - IT_FFN13, w3, DM, DFF, dst, DM, 0, 2, scr, lane);
    }
}
__device__ __forceinline__ void transpose_w2(const float* w2, bf16_t* dst, LAS float* scr, int gw, int NGW, int lane) {
    for (int r = gw; r < IT_FFN2; r += NGW) { const int nblk = DM / 32, kb = r / nblk, nb = r - kb * nblk; transpose_item(w2, DM, 64 * kb, 32 * nb, dst + ((size_t)kb * DM + 32 * nb) * 64, 64, scr, lane); }
}

template <bool SRC_BF16>
__device__ __forceinline__ void load_row(const void* srcP, const void* srcS, int r, int lane, f32x4 (&v)[8]) {
    if (SRC_BF16) { const u32x2* xr = (const u32x2*)((const bf16_t*)srcP + (size_t)r * DM) + lane;
#pragma unroll
        for (int j = 0; j < 8; ++j) { const u32x2 w = __builtin_nontemporal_load(xr + 64 * j); v[j] = (f32x4){bf_lo(w.x), bf_hi(w.x), bf_lo(w.y), bf_hi(w.y)}; } }
    else { const f32x4* xr = (const f32x4*)(r < MP ? (const float*)srcP + (size_t)r * DM : (const float*)srcS + (size_t)(r - MP) * DM) + lane;
#pragma unroll
        for (int j = 0; j < 8; ++j) v[j] = __builtin_nontemporal_load(xr + 64 * j); }
}
template <bool SRC_BF16>
__device__ __forceinline__ void norm_phase(const void* srcP, const void* srcS, const float* g, const float* mod, int sub, bf16_t* H, int gw, int NGW, int lane) {
    const int R = (MT + NGW - 1) / NGW, r0 = gw * R, r1 = (r0 + R < MT) ? r0 + R : MT;
    if (r0 >= r1) return;
    int cur = -1; f32x4 gs[8], sh[8], v[8], nv[8];
    load_row<SRC_BF16>(srcP, srcS, r0, lane, v);
    for (int r = r0; r < r1; ++r) {
        if (r + 1 < r1) load_row<SRC_BF16>(srcP, srcS, r + 1, lane, nv);
        const int mr = mrow(r);
        if (mr != cur) { cur = mr; const f32x4* g4 = (const f32x4*)g + lane; const f32x4* m4 = (const f32x4*)(mod + (size_t)mr * MODW + sub * 3 * DM) + lane;
#pragma unroll
            for (int j = 0; j < 8; ++j) { gs[j] = g4[64 * j] * (m4[512 + 64 * j] + 1.0f); sh[j] = m4[64 * j]; } }
        float ss = 0.f;
#pragma unroll
        for (int j = 0; j < 8; ++j) ss += (v[j][0] * v[j][0] + v[j][1] * v[j][1]) + (v[j][2] * v[j][2] + v[j][3] * v[j][3]);
        const float rstd = rsqrtf(wave_sum(ss) * (1.0f / DM) + EPS);
        u32x2* o = (u32x2*)(H + (size_t)r * DM) + lane;
#pragma unroll
        for (int j = 0; j < 8; ++j) { const f32x4 h = v[j] * rstd * gs[j] + sh[j]; u32x2 w; w.x = cvt_pk_bf16(h[0], h[1]); w.y = cvt_pk_bf16(h[2], h[3]); o[64 * j] = w; }
#pragma unroll
        for (int j = 0; j < 8; ++j) v[j] = nv[j];
    }
}

constexpr int VNT_LD = 136;
constexpr int KS_LD = 72;
constexpr int VT_LD = 200;
constexpr int VT_OFF = 192 * KS_LD * 2;

__device__ __forceinline__ void spatial_unit(LAS unsigned char* lds, const Args& a, int row0, int nrows, int g, int sb) {
    const int tid = threadIdx.x, w = __builtin_amdgcn_readfirstlane(tid >> 6), lane = tid & 63;
    unsigned char* ws = a.ws;
    const bf16_t* GV = (const bf16_t*)(ws + WS_GV); const bf16_t* U = (const bf16_t*)(ws + WS_U); bf16_t* AO = (bf16_t*)(ws + WS_AO);
    const f32x2* stats = (const f32x2*)(ws + WS_STATS);
    const float* lng = a.in[16]; const float* lnb = a.in[17]; const float* w_s = a.in[18]; const float* b_s = a.in[19];
    LAS bf16_t* vnT = (LAS bf16_t*)lds;
    __syncthreads();
    {
        const int j = tid >> 2, cq = tid & 3;
        if (j < nrows) {
            const int row = row0 + j;
            const f32x4* st = (const f32x4*)(stats + (size_t)row * 16);
            float s1 = 0.f, s2 = 0.f;
#pragma unroll
            for (int i = 0; i < 8; ++i) { const f32x4 p = st[i]; s1 += p[0] + p[2]; s2 += p[1] + p[3]; }
            const float mean = s1 * (1.0f / 1024.0f), var = s2 * (1.0f / 1024.0f) - mean * mean, rstd = rsqrtf(var + EPS);
            const u32x4* src = (const u32x4*)(GV + (size_t)row * 1024 + 128 * g + 32 * cq);
#pragma unroll
            for (int q = 0; q < 4; ++q) {
                const u32x4 pk = __builtin_nontemporal_load(src + q); const int c0 = 32 * cq + 8 * q;
                const f32x4 ga = *(const f32x4*)(lng + 128 * g + c0), gb = *(const f32x4*)(lng + 128 * g + c0 + 4), ba = *(const f32x4*)(lnb + 128 * g + c0), bb = *(const f32x4*)(lnb + 128 * g + c0 + 4);
                f32x4 x0 = (f32x4){bf_lo(pk.x), bf_hi(pk.x), bf_lo(pk.y), bf_hi(pk.y)}, x1 = (f32x4){bf_lo(pk.z), bf_hi(pk.z), bf_lo(pk.w), bf_hi(pk.w)};
                x0 = (x0 - mean) * rstd * ga + ba; x1 = (x1 - mean) * rstd * gb + bb;
                if (sb >= 0) { float* o = a.out + O_GV + (size_t)(sb * 32 + j) * 1024 + 128 * g + c0; *(f32x4*)o = x0; *(f32x4*)(o + 4) = x1; }
                const unsigned p0 = cvt_pk_bf16(x0[0], x0[1]), p1 = cvt_pk_bf16(x0[2], x0[3]), p2 = cvt_pk_bf16(x1[0], x1[1]), p3 = cvt_pk_bf16(x1[2], x1[3]);
                vnT[(c0 + 0) * VNT_LD + j] = (bf16_t)(p0 & 0xffff); vnT[(c0 + 1) * VNT_LD + j] = (bf16_t)(p0 >> 16);
                vnT[(c0 + 2) * VNT_LD + j] = (bf16_t)(p1 & 0xffff); vnT[(c0 + 3) * VNT_LD + j] = (bf16_t)(p1 >> 16);
                vnT[(c0 + 4) * VNT_LD + j] = (bf16_t)(p2 & 0xffff); vnT[(c0 + 5) * VNT_LD + j] = (bf16_t)(p2 >> 16);
                vnT[(c0 + 6) * VNT_LD + j] = (bf16_t)(p3 & 0xffff); vnT[(c0 + 7) * VNT_LD + j] = (bf16_t)(p3 >> 16);
            }
        } else {
#pragma unroll 8
            for (int c = 0; c < 32; ++c) vnT[(32 * cq + c) * VNT_LD + j] = (bf16_t)0;
        }
    }
    const int il = lane & 15, kg = lane >> 4, i = 16 * w + il;
    const int nks = (sb >= 0) ? 1 : (w < 4 ? 2 : 4);
    bf16x8 Bf[4];
#pragma unroll
    for (int ks = 0; ks < 4; ++ks) {
        if (ks < nks) { const float* wp = w_s + (size_t)g * 16384 + i * 128 + 32 * ks + 8 * kg; const f32x4 a0 = *(const f32x4*)wp, a1 = *(const f32x4*)(wp + 4);
            u32x4 pk; pk.x = cvt_pk_bf16(a0[0], a0[1]); pk.y = cvt_pk_bf16(a0[2], a0[3]); pk.z = cvt_pk_bf16(a1[0], a1[1]); pk.w = cvt_pk_bf16(a1[2], a1[3]);
            Bf[ks] = __builtin_bit_cast(bf16x8, pk); }
        else Bf[ks] = (bf16x8){0, 0, 0, 0, 0, 0, 0, 0};
    }
    __syncthreads();
    if (sb >= 0 && w >= 2) return;
    f32x4 acc[8];
#pragma unroll
    for (int cb = 0; cb < 8; ++cb) {
        acc[cb] = (f32x4){0.f, 0.f, 0.f, 0.f};
#pragma unroll
        for (int ks = 0; ks < 4; ++ks)
            if (ks < nks) { const bf16x8 Af = *(const LAS bf16x8*)(vnT + (16 * cb + il) * VNT_LD + 32 * ks + 8 * kg);
                acc[cb] = __builtin_amdgcn_mfma_f32_16x16x32_bf16(Af, Bf[ks], acc[cb], 0, 0, 0); }
    }
    if (i < nrows) {
        const float bs = b_s[g * 128 + i]; const size_t row = (size_t)(row0 + i);
        u32x2 uw[8];
#pragma unroll
        for (int cb = 0; cb < 8; ++cb) uw[cb] = __builtin_nontemporal_load((const u32x2*)(U + row * 1024 + 128 * g + 16 * cb + 4 * kg));
#pragma unroll
        for (int cb = 0; cb < 8; ++cb) {
            const int c = 128 * g + 16 * cb + 4 * kg;
            const f32x4 uu = (f32x4){bf_lo(uw[cb].x), bf_hi(uw[cb].x), bf_lo(uw[cb].y), bf_hi(uw[cb].y)};
            const f32x4 r = uu * (acc[cb] + bs);
            u32x2 o; o.x = cvt_pk_bf16(r[0], r[1]); o.y = cvt_pk_bf16(r[2], r[3]);
            *(u32x2*)(AO + row * 2048 + c) = o;
        }
    }
}

__device__ __forceinline__ void attn_unit(LAS unsigned char* lds, const Args& a, int b, int cn, int kvh, int sb) {
    const int tid = threadIdx.x, w = __builtin_amdgcn_readfirstlane(tid >> 6), lane = tid & 63, il = lane & 15, kg = lane >> 4;
    unsigned char* ws = a.ws;
    const bf16_t* Q = (const bf16_t*)(ws + WS_Q); const bf16_t* Kb = (const bf16_t*)(ws + WS_K); const bf16_t* Vb = (const bf16_t*)(ws + WS_V); bf16_t* AO = (bf16_t*)(ws + WS_AO);
    LAS bf16_t* Ks = (LAS bf16_t*)lds; LAS bf16_t* VT = (LAS bf16_t*)(lds + VT_OFF);
    const bool samp = sb >= 0;
    __syncthreads();
#pragma unroll
    for (int p = 0; p < 3; ++p) {
        const int idx = p * NTHR + tid, key = idx >> 3, part = idx & 7;
        u32x4 k8 = (u32x4){0u, 0u, 0u, 0u}, v8 = (u32x4){0u, 0u, 0u, 0u};
        if (!samp) {
            const int pos = 64 * (cn - 2) + key;
            if (pos >= 0) { const size_t off = (size_t)(b * SEQ + pos) * 256 + kvh * 64 + part * 8; k8 = *(const u32x4*)(Kb + off); v8 = *(const u32x4*)(Vb + off); }
        } else if (key < 128) {
            const size_t off = ((size_t)(sb * 128 + key) * 4 + kvh) * 64 + part * 8;
            const f32x4 k0 = *(const f32x4*)(a.in[2] + off), k1 = *(const f32x4*)(a.in[2] + off + 4), v0 = *(const f32x4*)(a.in[3] + off), v1 = *(const f32x4*)(a.in[3] + off + 4);
            k8.x = cvt_pk_bf16(k0[0], k0[1]); k8.y = cvt_pk_bf16(k0[2], k0[3]); k8.z = cvt_pk_bf16(k1[0], k1[1]); k8.w = cvt_pk_bf16(k1[2], k1[3]);
            v8.x = cvt_pk_bf16(v0[0], v0[1]); v8.y = cvt_pk_bf16(v0[2], v0[3]); v8.z = cvt_pk_bf16(v1[0], v1[1]); v8.w = cvt_pk_bf16(v1[2], v1[3]);
        } else if (key < 160) {
            const size_t off = (size_t)(MP + sb * 32 + key - 128) * 256 + kvh * 64 + part * 8; k8 = *(const u32x4*)(Kb + off); v8 = *(const u32x4*)(Vb + off);
        }
        *(LAS u32x4*)(Ks + key * KS_LD + part * 8) = k8;
        LAS bf16_t* vt = VT + (part * 8) * VT_LD + key;
        vt[0 * VT_LD] = (bf16_t)(v8.x & 0xffff); vt[1 * VT_LD] = (bf16_t)(v8.x >> 16); vt[2 * VT_LD] = (bf16_t)(v8.y & 0xffff); vt[3 * VT_LD] = (bf16_t)(v8.y >> 16);
        vt[4 * VT_LD] = (bf16_t)(v8.z & 0xffff); vt[5 * VT_LD] = (bf16_t)(v8.z >> 16); vt[6 * VT_LD] = (bf16_t)(v8.w & 0xffff); vt[7 * VT_LD] = (bf16_t)(v8.w >> 16);
    }
    const int hq = 4 * kvh + (w >> 1);
    const int qrow0 = samp ? MP + sb * 32 + (w & 1) * 16 : b * SEQ + 64 * cn + (w & 1) * 32;
    const int kb_lo = samp ? 0 : (cn < 2 ? 4 * (2 - cn) : 0), kb_hi = samp ? 10 : 12;
    bf16x8 Qf[2][2];
#pragma unroll
    for (int qb = 0; qb < 2; ++qb) { const int row = qrow0 + ((samp && qb) ? 0 : 16 * qb) + il;
#pragma unroll
        for (int ks = 0; ks < 2; ++ks) Qf[qb][ks] = *(const bf16x8*)(Q + (size_t)row * 1024 + hq * 64 + 32 * ks + 8 * kg); }
    __syncthreads();
    f32x4 S[2][12];
#pragma unroll
    for (int kb = 0; kb < 12; ++kb) {
#pragma unroll
        for (int qb = 0; qb < 2; ++qb) S[qb][kb] = (f32x4){0.f, 0.f, 0.f, 0.f};
        if (kb >= kb_lo && kb < kb_hi) {
#pragma unroll
            for (int ks = 0; ks < 2; ++ks) { const bf16x8 Kf = *(const LAS bf16x8*)(Ks + (16 * kb + il) * KS_LD + 32 * ks + 8 * kg);
#pragma unroll
                for (int qb = 0; qb < 2; ++qb) S[qb][kb] = __builtin_amdgcn_mfma_f32_16x16x32_bf16(Kf, Qf[qb][ks], S[qb][kb], 0, 0, 0); }
        }
    }
    const float sink = a.in[20][hq];
    float linv[2];
#pragma unroll
    for (int qb = 0; qb < 2; ++qb) {
        float mx = sink;
#pragma unroll
        for (int kb = 0; kb < 12; ++kb) if (kb >= kb_lo && kb < kb_hi) {
#pragma unroll
            for (int e = 0; e < 4; ++e) { S[qb][kb][e] *= 0.125f; mx = fmaxf(mx, S[qb][kb][e]); } }
        mx = fmaxf(mx, __shfl_xor(mx, 16)); mx = fmaxf(mx, __shfl_xor(mx, 32));
        float l = 0.f;
#pragma unroll
        for (int kb = 0; kb < 12; ++kb) {
            if (kb >= kb_lo && kb < kb_hi) {
#pragma unroll
                for (int e = 0; e < 4; ++e) { const float p = __expf(S[qb][kb][e] - mx); S[qb][kb][e] = p; l += p; }
            } else S[qb][kb] = (f32x4){0.f, 0.f, 0.f, 0.f};
        }
        l += __shfl_xor(l, 16); l += __shfl_xor(l, 32);
        l += __expf(sink - mx);
        linv[qb] = 1.0f / l;
    }
    f32x4 O[2][4];
#pragma unroll
    for (int qb = 0; qb < 2; ++qb)
#pragma unroll
        for (int db = 0; db < 4; ++db) O[qb][db] = (f32x4){0.f, 0.f, 0.f, 0.f};
#pragma unroll
    for (int t = 0; t < 6; ++t) {
        if (2 * t + 1 >= kb_lo && 2 * t < kb_hi) {
            bf16x8 Pf[2];
#pragma unroll
            for (int qb = 0; qb < 2; ++qb) { u32x4 pk; pk.x = cvt_pk_bf16(S[qb][2 * t][0], S[qb][2 * t][1]); pk.y = cvt_pk_bf16(S[qb][2 * t][2], S[qb][2 * t][3]);
                pk.z = cvt_pk_bf16(S[qb][2 * t + 1][0], S[qb][2 * t + 1][1]); pk.w = cvt_pk_bf16(S[qb][2 * t + 1][2], S[qb][2 * t + 1][3]); Pf[qb] = __builtin_bit_cast(bf16x8, pk); }
#pragma unroll
            for (int db = 0; db < 4; ++db) {
                const LAS bf16_t* vp = VT + (16 * db + il) * VT_LD + 32 * t + 4 * kg;
                const u32x2 lo = *(const LAS u32x2*)vp, hi = *(const LAS u32x2*)(vp + 16);
                const bf16x8 Vf = __builtin_bit_cast(bf16x8, (u32x4){lo.x, lo.y, hi.x, hi.y});
#pragma unroll
                for (int qb = 0; qb < 2; ++qb) O[qb][db] = __builtin_amdgcn_mfma_f32_16x16x32_bf16(Vf, Pf[qb], O[qb][db], 0, 0, 0);
            }
        }
    }
#pragma unroll
    for (int qb = 0; qb < 2; ++qb) {
        if (samp && qb) continue;
        const size_t row = (size_t)(qrow0 + 16 * qb + il);
#pragma unroll
        for (int db = 0; db < 4; ++db) { const f32x4 r = O[qb][db] * linv[qb]; u32x2 o; o.x = cvt_pk_bf16(r[0], r[1]); o.y = cvt_pk_bf16(r[2], r[3]);
            *(u32x2*)(AO + row * 2048 + 1024 + hq * 64 + 16 * db + 4 * kg) = o; }
    }
}


struct AttnPre { u32x4 k8[3], v8[3]; bf16x8 qf[2][2]; };
__device__ __forceinline__ void attn_pre_load(const Args& a, int it, AttnPre& P) {
    const int tid = threadIdx.x, w = __builtin_amdgcn_readfirstlane(tid >> 6), lane = tid & 63, il = lane & 15, kg = lane >> 4;
    const bf16_t* Q = (const bf16_t*)(a.ws + WS_Q); const bf16_t* Kb = (const bf16_t*)(a.ws + WS_K); const bf16_t* Vb = (const bf16_t*)(a.ws + WS_V);
    const int b = it >> 9, cn = (it >> 2) & 127, kvh = it & 3;
#pragma unroll
    for (int p = 0; p < 3; ++p) {
        const int idx = p * NTHR + tid, key = idx >> 3, part = idx & 7, pos = 64 * (cn - 2) + key;
        P.k8[p] = (u32x4){0u, 0u, 0u, 0u}; P.v8[p] = (u32x4){0u, 0u, 0u, 0u};
        if (pos >= 0) { const size_t off = (size_t)(b * SEQ + pos) * 256 + kvh * 64 + part * 8; P.k8[p] = *(const u32x4*)(Kb + off); P.v8[p] = *(const u32x4*)(Vb + off); }
    }
    const int hq = 4 * kvh + (w >> 1), qrow0 = b * SEQ + 64 * cn + (w & 1) * 32;
#pragma unroll
    for (int qb = 0; qb < 2; ++qb)
#pragma unroll
        for (int ks = 0; ks < 2; ++ks) P.qf[qb][ks] = *(const bf16x8*)(Q + (size_t)(qrow0 + 16 * qb + il) * 1024 + hq * 64 + 32 * ks + 8 * kg);
}
__device__ __forceinline__ void attn_prompt_loop(LAS unsigned char* lds, const Args& a, int bx, int G) {
    const int tid = threadIdx.x, w = __builtin_amdgcn_readfirstlane(tid >> 6), lane = tid & 63, il = lane & 15, kg = lane >> 4;
    bf16_t* AO = (bf16_t*)(a.ws + WS_AO);
    LAS bf16_t* Ks = (LAS bf16_t*)lds; LAS bf16_t* VT = (LAS bf16_t*)(lds + VT_OFF);
    AttnPre P;
    if (bx < 2048) attn_pre_load(a, bx, P);
    for (int it = bx; it < 2048; it += G) {
        const int b = it >> 9, cn = (it >> 2) & 127, kvh = it & 3;
        __syncthreads();
#pragma unroll
        for (int p = 0; p < 3; ++p) {
            const int idx = p * NTHR + tid, key = idx >> 3, part = idx & 7;
            const u32x4 k8 = P.k8[p], v8 = P.v8[p];
            *(LAS u32x4*)(Ks + key * KS_LD + part * 8) = k8;
            LAS bf16_t* vt = VT + (part * 8) * VT_LD + key;
            vt[0 * VT_LD] = (bf16_t)(v8.x & 0xffff); vt[1 * VT_LD] = (bf16_t)(v8.x >> 16); vt[2 * VT_LD] = (bf16_t)(v8.y & 0xffff); vt[3 * VT_LD] = (bf16_t)(v8.y >> 16);
            vt[4 * VT_LD] = (bf16_t)(v8.z & 0xffff); vt[5 * VT_LD] = (bf16_t)(v8.z >> 16); vt[6 * VT_LD] = (bf16_t)(v8.w & 0xffff); vt[7 * VT_LD] = (bf16_t)(v8.w >> 16);
        }
        bf16x8 Qf[2][2];
#pragma unroll
        for (int qb = 0; qb < 2; ++qb)
#pragma unroll
            for (int ks = 0; ks < 2; ++ks) Qf[qb][ks] = P.qf[qb][ks];
        if (it + G < 2048) attn_pre_load(a, it + G, P);
        __syncthreads();
        const int hq = 4 * kvh + (w >> 1), qrow0 = b * SEQ + 64 * cn + (w & 1) * 32;
        const int kb_lo = cn < 2 ? 4 * (2 - cn) : 0;
        f32x4 S[2][12];
#pragma unroll
        for (int kb = 0; kb < 12; ++kb) {
#pragma unroll
            for (int qb = 0; qb < 2; ++qb) S[qb][kb] = (f32x4){0.f, 0.f, 0.f, 0.f};
            if (kb >= kb_lo) {
#pragma unroll
                for (int ks = 0; ks < 2; ++ks) { const bf16x8 Kf = *(const LAS bf16x8*)(Ks + (16 * kb + il) * KS_LD + 32 * ks + 8 * kg);
#pragma unroll
                    for (int qb = 0; qb < 2; ++qb) S[qb][kb] = __builtin_amdgcn_mfma_f32_16x16x32_bf16(Kf, Qf[qb][ks], S[qb][kb], 0, 0, 0); }
            }
        }
        const float sink = a.in[20][hq];
        float linv[2];
#pragma unroll
        for (int qb = 0; qb < 2; ++qb) {
            float mx = sink;
#pragma unroll
            for (int kb = 0; kb < 12; ++kb) if (kb >= kb_lo) {
#pragma unroll
                for (int e = 0; e < 4; ++e) { S[qb][kb][e] *= 0.125f; mx = fmaxf(mx, S[qb][kb][e]); } }
            mx = fmaxf(mx, __shfl_xor(mx, 16)); mx = fmaxf(mx, __shfl_xor(mx, 32));
            float l = 0.f;
#pragma unroll
            for (int kb = 0; kb < 12; ++kb) {
                if (kb >= kb_lo) {
#pragma unroll
                    for (int e = 0; e < 4; ++e) { const float pv = __expf(S[qb][kb][e] - mx); S[qb][kb][e] = pv; l += pv; }
                } else S[qb][kb] = (f32x4){0.f, 0.f, 0.f, 0.f};
            }
            l += __shfl_xor(l, 16); l += __shfl_xor(l, 32);
            l += __expf(sink - mx);
            linv[qb] = 1.0f / l;
        }
        f32x4 O[2][4];
#pragma unroll
        for (int qb = 0; qb < 2; ++qb)
#pragma unroll
            for (int db = 0; db < 4; ++db) O[qb][db] = (f32x4){0.f, 0.f, 0.f, 0.f};
#pragma unroll
        for (int t = 0; t < 6; ++t) {
            if (2 * t + 1 >= kb_lo) {
                bf16x8 Pf[2];
#pragma unroll
                for (int qb = 0; qb < 2; ++qb) { u32x4 pk; pk.x = cvt_pk_bf16(S[qb][2 * t][0], S[qb][2 * t][1]); pk.y = cvt_pk_bf16(S[qb][2 * t][2], S[qb][2 * t][3]);
                    pk.z = cvt_pk_bf16(S[qb][2 * t + 1][0], S[qb][2 * t + 1][1]); pk.w = cvt_pk_bf16(S[qb][2 * t + 1][2], S[qb][2 * t + 1][3]); Pf[qb] = __builtin_bit_cast(bf16x8, pk); }
#pragma unroll
                for (int db = 0; db < 4; ++db) {
                    const LAS bf16_t* vp = VT + (16 * db + il) * VT_LD + 32 * t + 4 * kg;
                    const u32x2 lo = *(const LAS u32x2*)vp, hi = *(const LAS u32x2*)(vp + 16);
                    const bf16x8 Vf = __builtin_bit_cast(bf16x8, (u32x4){lo.x, lo.y, hi.x, hi.y});
#pragma unroll
                    for (int qb = 0; qb < 2; ++qb) O[qb][db] = __builtin_amdgcn_mfma_f32_16x16x32_bf16(Vf, Pf[qb], O[qb][db], 0, 0, 0);
                }
            }
        }
#pragma unroll
        for (int qb = 0; qb < 2; ++qb) {
            const size_t row = (size_t)(qrow0 + 16 * qb + il);
#pragma unroll
            for (int db = 0; db < 4; ++db) { const f32x4 r = O[qb][db] * linv[qb]; u32x2 o; o.x = cvt_pk_bf16(r[0], r[1]); o.y = cvt_pk_bf16(r[2], r[3]);
                *(u32x2*)(AO + row * 2048 + 1024 + hq * 64 + 16 * db + 4 * kg) = o; }
        }
    }
}

struct SpPre { f32x4 st[2]; u32x4 gv[4]; u32x2 uw[8]; };
__device__ __forceinline__ void sp_pre_load(const Args& a, int it, SpPre& P) {
    const int tid = threadIdx.x, w = __builtin_amdgcn_readfirstlane(tid >> 6), lane = tid & 63, il = lane & 15, kg = lane >> 4;
    const bf16_t* GV = (const bf16_t*)(a.ws + WS_GV); const bf16_t* U = (const bf16_t*)(a.ws + WS_U); const f32x2* stats = (const f32x2*)(a.ws + WS_STATS);
    const int g = it & 7, row0 = (it >> 3) * 128, j = tid >> 2, cq = tid & 3;
    const f32x4* st = (const f32x4*)(stats + (size_t)(row0 + j) * 16) + 2 * cq;
    P.st[0] = st[0]; P.st[1] = st[1];
    const u32x4* src = (const u32x4*)(GV + (size_t)(row0 + j) * 1024 + 128 * g + 32 * cq);
#pragma unroll
    for (int q = 0; q < 4; ++q) P.gv[q] = __builtin_nontemporal_load(src + q);
    const size_t urow = (size_t)(row0 + 16 * w + il);
#pragma unroll
    for (int cb = 0; cb < 8; ++cb) P.uw[cb] = __builtin_nontemporal_load((const u32x2*)(U + urow * 1024 + 128 * g + 16 * cb + 4 * kg));
}
__device__ __forceinline__ void spatial_prompt_loop(LAS unsigned char* lds, const Args& a, int bx, int G) {
    const int tid = threadIdx.x, w = __builtin_amdgcn_readfirstlane(tid >> 6), lane = tid & 63, il = lane & 15, kg = lane >> 4;
    bf16_t* AO = (bf16_t*)(a.ws + WS_AO);
    const float* lng = a.in[16]; const float* lnb = a.in[17]; const float* w_s = a.in[18]; const float* b_s = a.in[19];
    LAS bf16_t* vnT = (LAS bf16_t*)lds;
    SpPre P;
    if (bx < 2048) sp_pre_load(a, bx, P);
    for (int it = bx; it < 2048; it += G) {
        const int g = it & 7, row0 = (it >> 3) * 128;
        __syncthreads();
        {
            const int j = tid >> 2, cq = tid & 3;
            float s1 = (P.st[0][0] + P.st[0][2]) + (P.st[1][0] + P.st[1][2]), s2 = (P.st[0][1] + P.st[0][3]) + (P.st[1][1] + P.st[1][3]);
            s1 += __shfl_xor(s1, 1); s1 += __shfl_xor(s1, 2); s2 += __shfl_xor(s2, 1); s2 += __shfl_xor(s2, 2);
            const float mean = s1 * (1.0f / 1024.0f), var = s2 * (1.0f / 1024.0f) - mean * mean, rstd = rsqrtf(var + EPS);
#pragma unroll
            for (int q = 0; q < 4; ++q) {
                const u32x4 pk = P.gv[q]; const int c0 = 32 * cq + 8 * q;
                const f32x4 ga = *(const f32x4*)(lng + 128 * g + c0), gb = *(const f32x4*)(lng + 128 * g + c0 + 4), ba = *(const f32x4*)(lnb + 128 * g + c0), bb = *(const f32x4*)(lnb + 128 * g + c0 + 4);
                f32x4 x0 = (f32x4){bf_lo(pk.x), bf_hi(pk.x), bf_lo(pk.y), bf_hi(pk.y)}, x1 = (f32x4){bf_lo(pk.z), bf_hi(pk.z), bf_lo(pk.w), bf_hi(pk.w)};
                x0 = (x0 - mean) * rstd * ga + ba; x1 = (x1 - mean) * rstd * gb + bb;
                const unsigned p0 = cvt_pk_bf16(x0[0], x0[1]), p1 = cvt_pk_bf16(x0[2], x0[3]), p2 = cvt_pk_bf16(x1[0], x1[1]), p3 = cvt_pk_bf16(x1[2], x1[3]);
                vnT[(c0 + 0) * VNT_LD + j] = (bf16_t)(p0 & 0xffff); vnT[(c0 + 1) * VNT_LD + j] = (bf16_t)(p0 >> 16);
                vnT[(c0 + 2) * VNT_LD + j] = (bf16_t)(p1 & 0xffff); vnT[(c0 + 3) * VNT_LD + j] = (bf16_t)(p1 >> 16);
                vnT[(c0 + 4) * VNT_LD + j] = (bf16_t)(p2 & 0xffff); vnT[(c0 + 5) * VNT_LD + j] = (bf16_t)(p2 >> 16);
                vnT[(c0 + 6) * VNT_LD + j] = (bf16_t)(p3 & 0xffff); vnT[(c0 + 7) * VNT_LD + j] = (bf16_t)(p3 >> 16);
            }
        }
        u32x2 uw[8];
#pragma unroll
        for (int cb = 0; cb < 8; ++cb) uw[cb] = P.uw[cb];
        const int i = 16 * w + il, nks = w < 4 ? 2 : 4;
        bf16x8 Bf[4];
#pragma unroll
        for (int ks = 0; ks < 4; ++ks) {
            if (ks < nks) { const float* wp = w_s + (size_t)g * 16384 + i * 128 + 32 * ks + 8 * kg; const f32x4 a0 = *(const f32x4*)wp, a1 = *(const f32x4*)(wp + 4);
                u32x4 pk; pk.x = cvt_pk_bf16(a0[0], a0[1]); pk.y = cvt_pk_bf16(a0[2], a0[3]); pk.z = cvt_pk_bf16(a1[0], a1[1]); pk.w = cvt_pk_bf16(a1[2], a1[3]);
                Bf[ks] = __builtin_bit_cast(bf16x8, pk); }
            else Bf[ks] = (bf16x8){0, 0, 0, 0, 0, 0, 0, 0};
        }
        const float bs = b_s[g * 128 + i];
        if (it + G < 2048) sp_pre_load(a, it + G, P);
        __syncthreads();
        f32x4 acc[8];
#pragma unroll
        for (int cb = 0; cb < 8; ++cb) {
            acc[cb] = (f32x4){0.f, 0.f, 0.f, 0.f};
#pragma unroll
            for (int ks = 0; ks < 4; ++ks)
                if (ks < nks) { const bf16x8 Af = *(const LAS bf16x8*)(vnT + (16 * cb + il) * VNT_LD + 32 * ks + 8 * kg);
                    acc[cb] = __builtin_amdgcn_mfma_f32_16x16x32_bf16(Af, Bf[ks], acc[cb], 0, 0, 0); }
        }
        const size_t row = (size_t)(row0 + i);
#pragma unroll
        for (int cb = 0; cb < 8; ++cb) {
            const f32x4 uu = (f32x4){bf_lo(uw[cb].x), bf_hi(uw[cb].x), bf_lo(uw[cb].y), bf_hi(uw[cb].y)};
            const f32x4 r = uu * (acc[cb] + bs);
            u32x2 o; o.x = cvt_pk_bf16(r[0], r[1]); o.y = cvt_pk_bf16(r[2], r[3]);
            *(u32x2*)(AO + row * 2048 + 128 * g + 16 * cb + 4 * kg) = o;
        }
    }
}

#define XB_TMO      128
#define XB_XCNT(j)  (256  + 64 * (j))
#define XB_XSUB(j)  (1280 + 64 * (j))
#define XB_XGEN(j)  (2304 + 64 * (j))
#define XB_TOP      3328
#define XB_TOPGEN   3392
#define XCD_BAR_WORDS 3456
#define XB_SPIN_CAP (1u << 18)
__device__ __forceinline__ unsigned xb_ld(unsigned* p)              { return __hip_atomic_load(p, __ATOMIC_RELAXED, __HIP_MEMORY_SCOPE_AGENT); }
__device__ __forceinline__ unsigned xb_add(unsigned* p, unsigned v) { return __hip_atomic_fetch_add(p, v, __ATOMIC_RELAXED, __HIP_MEMORY_SCOPE_AGENT); }
__device__ __forceinline__ unsigned xb_xcc_id() { return (unsigned)__builtin_amdgcn_s_getreg((3 << 11) | 20) & 0xFu; }
#define XB_SPIN(cond, bar) do { unsigned _sp = 0; while (cond) { __builtin_amdgcn_s_sleep(1); \
    if ((++_sp & 255u) == 0u) { if (xb_ld(&(bar)[XB_TMO])) break; if (_sp > XB_SPIN_CAP) { atomicAdd(&(bar)[XB_TMO], 1u); break; } } } } while (0)
struct XcdBarrier { unsigned* bar; unsigned x; volatile LAS unsigned* st; };
__device__ __forceinline__ XcdBarrier xcd_barrier_post(unsigned* bar, volatile LAS unsigned* st) {
    XcdBarrier b; b.bar = bar; b.x = xb_xcc_id(); b.st = st;
    if (threadIdx.x == 0) (void)xb_add(&bar[XB_XCNT(b.x)], 1u);
    return b;
}
__device__ __forceinline__ void xcd_barrier_complete(unsigned* bar, unsigned x, unsigned& nloc, unsigned& nx) {
    const unsigned G = gridDim.x * gridDim.y * gridDim.z;
    unsigned sum, cnt, mine, sp = 0u;
    for (;;) {
        sum = 0u; cnt = 0u; mine = 0u;
#pragma unroll
        for (unsigned j = 0; j < 16; ++j) { const unsigned c = xb_ld(&bar[XB_XCNT(j)]); sum += c; cnt += (c > 0u) ? 1u : 0u; mine = (j == x) ? c : mine; }
        if (sum == G) break;
        __builtin_amdgcn_s_sleep(1);
        if ((++sp & 255u) == 0u) { if (xb_ld(&bar[XB_TMO])) break; if (sp > XB_SPIN_CAP) { atomicAdd(&bar[XB_TMO], 1u); break; } }
    }
    nloc = mine > 0u ? mine : 1u; nx = cnt > 0u ? cnt : 1u;
}
__device__ __forceinline__ void xcd_barrier(const XcdBarrier& b) {
    asm volatile("s_waitcnt vmcnt(0)" ::: "memory");
    __syncthreads();
    if (threadIdx.x == 0) {
        unsigned* bar = b.bar;
        __builtin_amdgcn_s_waitcnt(0);
        unsigned nloc = b.st[0], nx = b.st[1];
        if (nloc == 0u) { xcd_barrier_complete(bar, b.x, nloc, nx); b.st[0] = nloc; b.st[1] = nx; }
        const unsigned old = xb_add(&bar[XB_XSUB(b.x)], 1u);
        const unsigned gen = old / nloc;
        if (old + 1u == (gen + 1u) * nloc) {
            __builtin_amdgcn_fence(__ATOMIC_RELEASE, "agent");
            asm volatile("s_waitcnt vmcnt(0)" ::: "memory");
            const unsigned og = xb_add(&bar[XB_TOP], 1u);
            const unsigned tg = og / nx;
            if (og + 1u == (tg + 1u) * nx) xb_add(&bar[XB_TOPGEN], 1u);
            else XB_SPIN(xb_ld(&bar[XB_TOPGEN]) == tg, bar);
            __builtin_amdgcn_fence(__ATOMIC_ACQUIRE, "agent");
            xb_add(&bar[XB_XGEN(b.x)], 1u);
            asm volatile("s_waitcnt vmcnt(0)" ::: "memory");
        } else {
            XB_SPIN(xb_ld(&bar[XB_XGEN(b.x)]) == gen, bar);
            __builtin_amdgcn_fence(__ATOMIC_ACQUIRE, "agent");
            asm volatile("s_waitcnt vmcnt(0)" ::: "memory");
        }
    }
    __syncthreads();
}

__device__ __forceinline__ f32x4 skinny_dot(const bf16_t* ap, const bf16_t* bp, int nks, f32x4 acc, size_t planeA = 64, size_t planeB = 64) {
#pragma unroll 8
    for (int ks = 0; ks < nks; ++ks) { const bf16x8 av = *(const bf16x8*)(ap + (size_t)(ks >> 1) * planeA + (ks & 1) * 32), bv = *(const bf16x8*)(bp + (size_t)(ks >> 1) * planeB + (ks & 1) * 32);
        acc = __builtin_amdgcn_mfma_f32_16x16x32_bf16(bv, av, acc, 0, 0, 0); }
    return acc;
}
template <bool BASE_BF16, bool OUT_BF16>
__device__ __forceinline__ void skinny_resid(const bf16_t* A, int lda, size_t planeA, const bf16_t* Bt, int ldb, size_t planeB, int K, const void* baseS, void* outS, const float* gate, float coef, int bx, int G) {
    const int tid = threadIdx.x, w = __builtin_amdgcn_readfirstlane(tid >> 6), lane = tid & 63, il = lane & 15, kg = lane >> 4;
    for (int it = bx; it < 256; it += G) {
        const int cb = it >> 1, r = (it & 1) * 128 + 16 * w + il, col = 16 * cb + 4 * kg;
        const f32x4 acc = skinny_dot(A + (size_t)(MP + r) * lda + 8 * kg, Bt + (size_t)(16 * cb + il) * ldb + 8 * kg, K / 32, (f32x4){0.f, 0.f, 0.f, 0.f}, planeA, planeB);
        const f32x4 gg = *(const f32x4*)(gate + (size_t)(4 + (r >> 5)) * MODW + col) * coef;
        f32x4 b;
        if (BASE_BF16) { const u32x2 bw = *(const u32x2*)((const bf16_t*)baseS + (size_t)r * DM + col); b = (f32x4){bf_lo(bw.x), bf_hi(bw.x), bf_lo(bw.y), bf_hi(bw.y)}; }
        else b = *(const f32x4*)((const float*)baseS + (size_t)r * DM + col);
        const f32x4 o = b + gg * acc;
        if (OUT_BF16) { u32x2 pk; pk.x = cvt_pk_bf16(o[0], o[1]); pk.y = cvt_pk_bf16(o[2], o[3]); *(u32x2*)((bf16_t*)outS + (size_t)r * DM + col) = pk; }
        else *(f32x4*)((float*)outS + (size_t)r * DM + col) = o;
    }
}
__device__ __forceinline__ void skinny_merge(const bf16_t* AO, const bf16_t* WPAB, const bf16_t* GA, const bf16_t* GB, bf16_t* Y, int bx, int G) {
    const int tid = threadIdx.x, w = __builtin_amdgcn_readfirstlane(tid >> 6), lane = tid & 63, il = lane & 15, kg = lane >> 4;
    for (int it = bx; it < 256; it += G) {
        const int cb = it >> 1, r = (it & 1) * 128 + 16 * w + il, col = 16 * cb + 4 * kg;
        const bf16_t* ap = AO + (size_t)(MP + r) * 2048 + 8 * kg; const bf16_t* bp = WPAB + (size_t)(16 * cb + il) * 2048 + 8 * kg;
        const f32x4 a1 = skinny_dot(ap, bp, 32, (f32x4){0.f, 0.f, 0.f, 0.f}), a2 = skinny_dot(ap + 1024, bp + 1024, 32, (f32x4){0.f, 0.f, 0.f, 0.f});
        const size_t o = (size_t)(MP + r) * DM + col;
        const u32x2 ga = *(const u32x2*)(GA + o), gb = *(const u32x2*)(GB + o);
        const f32x4 sa = (f32x4){bf_lo(ga.x), bf_hi(ga.x), bf_lo(ga.y), bf_hi(ga.y)}, sb = (f32x4){bf_lo(gb.x), bf_hi(gb.x), bf_lo(gb.y), bf_hi(gb.y)};
        const f32x4 y = sa * a1 + sb * a2;
        u32x2 pk; pk.x = cvt_pk_bf16(y[0], y[1]); pk.y = cvt_pk_bf16(y[2], y[3]);
        *(u32x2*)(Y + o) = pk;
    }
}

#ifndef STAG_TICKS
#define STAG_TICKS 800
#endif
__device__ __forceinline__ void stagger(int grp) {
    const unsigned long long t0 = __builtin_amdgcn_s_memrealtime(), want = (unsigned long long)grp * STAG_TICKS;
    while (__builtin_amdgcn_s_memrealtime() - t0 < want) __builtin_amdgcn_s_sleep(8);
}

__global__ void __launch_bounds__(NTHR, 2) fwd_kernel(Args a) {
    extern __shared__ __attribute__((aligned(16))) unsigned char lds_raw[];
    LAS unsigned char* lds = (LAS unsigned char*)lds_raw;
    const int tid = threadIdx.x, lane = tid & 63, wave = __builtin_amdgcn_readfirstlane(tid >> 6);
    const int G = gridDim.x, bx = blockIdx.x;
    const int gw = bx * NWAVES + wave, NGW = G * NWAVES;
    unsigned char* ws = a.ws; float* out = a.out;
    float* MOD = (float*)(ws + WS_MOD); f32x2* ROPE = (f32x2*)(ws + WS_ROPE); f32x2* STATS = (f32x2*)(ws + WS_STATS);
    bf16_t* W13 = (bf16_t*)(ws + WS_W13); bf16_t* W2 = (bf16_t*)(ws + WS_W2); bf16_t* WIN = (bf16_t*)(ws + WS_WIN); bf16_t* WPAB = (bf16_t*)(ws + WS_WPAB); bf16_t* WO = (bf16_t*)(ws + WS_WO);
    bf16_t* X1b = (bf16_t*)(ws + WS_X1); bf16_t* X2b = (bf16_t*)(ws + WS_X1 + 129 * MiB); bf16_t* H = (bf16_t*)(ws + WS_H); bf16_t* Gb = (bf16_t*)(ws + WS_G);
    const int lo = a.ph_lo, hi = a.ph_hi;
    volatile LAS unsigned* MISC = (volatile LAS unsigned*)(lds + LDS_BYTES - 64);
    if (tid < 16) MISC[tid] = 0u;
    __syncthreads();
    XcdBarrier bar; bar.bar = (unsigned*)ws; bar.x = 0; bar.st = nullptr;
    if (hi - lo > 1) bar = xcd_barrier_post((unsigned*)ws, MISC);
#define IN(k) (lo <= (k) && (k) < hi)
#define SEAM(k) do { if (IN(k) && IN((k) + 1)) xcd_barrier(bar); } while (0)
    if (hi < 0) cg::this_grid().sync();

    if (IN(0)) REPS(0) {
        {
            const float invf[8] = {1.0f, 0.1939227432012558f, 0.03760603070259094f, 0.007292664609849453f, 0.0014142135623842478f, 0.00027424818836152554f, 5.318296098266728e-05f, 1.0313386155758053e-05f};
            for (int i = bx * NTHR + tid; i < SEQ * 8; i += G * NTHR) {
                const int pos = i >> 3, f = i & 7;
                float fv = invf[0];
#pragma unroll
                for (int q = 1; q < 8; ++q) fv = (f == q) ? invf[q] : fv;
                const float ang = (float)pos * fv;
                const double ad = (double)ang; const double n = __builtin_rint(ad * 0.15915494309189535); const float rr = (float)(ad - n * 6.283185307179586);
                ROPE[i] = (f32x2){cosf(rr), sinf(rr)};
            }
            for (int i = bx * NTHR + tid; i < 8 * 24576 / 4; i += G * NTHR) {
                const int b = i / 6144, o = (i - b * 6144) * 4;
                *(f32x4*)(out + O_KS + (size_t)b * 32768 + o) = *(const f32x4*)(a.in[2] + (size_t)b * 32768 + 8192 + o);
                *(f32x4*)(out + O_VS + (size_t)b * 32768 + o) = *(const f32x4*)(a.in[3] + (size_t)b * 32768 + 8192 + o);
            }
        }
        {
            LAS float* sl = (LAS float*)lds;
            LAS float* red = (LAS float*)(lds + 98304);
            __syncthreads();
            for (int idx = tid; idx < 12 * 2048; idx += NTHR) { const int r = idx >> 11, k = idx & 2047; const float c = r < 4 ? a.in[4][r * 2048 + k] : a.in[5][(r - 4) * 2048 + k]; sl[k * 12 + r] = c * sigmoidf_(c); }
            __syncthreads();
            for (int cb = bx; cb < MODW / 64; cb += G) {
                float acc[12];
#pragma unroll
                for (int r = 0; r < 12; ++r) acc[r] = 0.f;
                const float* wp = a.in[6] + (size_t)(wave * 256) * MODW + cb * 64 + lane;
#pragma unroll 8
                for (int k = 0; k < 256; ++k) {
                    const float wv = __builtin_nontemporal_load(wp + (size_t)k * MODW);
                    const LAS f32x4* sp = (const LAS f32x4*)(sl + (wave * 256 + k) * 12);
                    const f32x4 s0 = sp[0], s1 = sp[1], s2 = sp[2];
                    acc[0] += s0[0] * wv; acc[1] += s0[1] * wv; acc[2] += s0[2] * wv; acc[3] += s0[3] * wv;
                    acc[4] += s1[0] * wv; acc[5] += s1[1] * wv; acc[6] += s1[2] * wv; acc[7] += s1[3] * wv;
                    acc[8] += s2[0] * wv; acc[9] += s2[1] * wv; acc[10] += s2[2] * wv; acc[11] += s2[3] * wv;
                }
#pragma unroll
                for (int r = 0; r < 12; ++r) red[(wave * 12 + r) * 64 + lane] = acc[r];
                __syncthreads();
                for (int o = tid; o < 768; o += NTHR) { const int r = o >> 6, cl = o & 63; float s = a.in[7][cb * 64 + cl];
#pragma unroll
                    for (int q = 0; q < 8; ++q) s += red[(q * 12 + r) * 64 + cl];
                    MOD[(size_t)r * MODW + cb * 64 + cl] = s; }
                __syncthreads();
            }
        }
        __syncthreads();
        {
            LAS float* scr = (LAS float*)(lds + wave * 8448);
            const int nx2 = (MODW / 64 > G && MODW / 64 < 2 * G) ? MODW / 64 - G : 0;
            const int head = nx2 ? 2 * (G - nx2) * NWAVES : 0;
            if (nx2 && bx >= nx2) transpose_w13(a.in[9], a.in[10], W13, scr, (bx - nx2) * NWAVES + wave, (G - nx2) * NWAVES, lane, 0, head);
            transpose_w13(a.in[9], a.in[10], W13, scr, gw, NGW, lane, head, 2 * IT_FFN13); transpose_w2(a.in[11], W2, scr, gw, NGW, lane);
            for (int it = gw; it < IT_WIN + 2 * IT_WP + IT_WO; it += NGW) {
                int r = it;
                if (r < IT_WIN) { tr_mat(r, a.in[13], DM, DIN, WIN, DM, 0, 3, scr, lane); continue; } r -= IT_WIN;
                if (r < IT_WP) { tr_mat(r, a.in[21], DA, DM, WPAB, 2048, 0, 0, scr, lane); continue; } r -= IT_WP;
                if (r < IT_WP) { tr_mat(r, a.in[22], DB, DM, WPAB, 2048, 1024, 0, scr, lane); continue; } r -= IT_WP;
                tr_mat(r, a.in[23], DM, DM, WO, DM, 0, 0, scr, lane);
            }
        }
    }
    SEAM(0);
    if (IN(1)) REPS(1) norm_phase<false>(a.in[0], a.in[1], a.in[8], MOD, 0, H, gw, NGW, lane);
    SEAM(1);
    bf16_t* W13B = (bf16_t*)(out + O_Y); bf16_t* W2B = (bf16_t*)(ws + WS_W2B);
    if (IN(2)) REPS(2) { pg8::Gemm g{H, W13, MT, 2 * DFF, DM, DM, DM, 128, 128}; pg8::StaticOrder S; S.init(MT, 2 * DFF, G, bx); EpiSwiGLU E{Gb}; pg8::gemm_phase(lds, g, S, E);
        const int rem = S.nwg % G;
        if (rem == 0) transpose_w13(a.in[25], a.in[26], W13B, (LAS float*)(lds + wave * 8448), gw, NGW, lane, 0, W13_SPLIT);
        else if (bx >= rem) transpose_w13(a.in[25], a.in[26], W13B, (LAS float*)(lds + wave * 8448), (bx - rem) * NWAVES + wave, (G - rem) * NWAVES, lane, 0, W13_SPLIT); }
    SEAM(2);
    if (IN(3)) REPS(3) { skinny_resid<false, true>(Gb, 64, (size_t)MT * 64, W2, 64, (size_t)DM * 64, DFF, a.in[1], X1b + (size_t)MP * DM, MOD + 0 * 3 * DM + 2 * DM, 0.5f, bx, G);
        pg8::Gemm g{Gb, W2, MP, DM, DFF, 64, 64, (size_t)MT * 128, (size_t)DM * 128}; pg8::StaticOrder S; S.init(MP, DM, G, bx, 4); EpiResid<false, true> E{a.in[0], a.in[1], X1b, MOD + 0 * 3 * DM + 2 * DM, 0.5f}; pg8::gemm_phase(lds, g, S, E); }
    SEAM(3);
    if (IN(4)) REPS(4) {
        norm_phase<true>(X1b, nullptr, a.in[12], MOD, 1, H, gw, NGW, lane);
    }
    SEAM(4);
    if (IN(5)) REPS(5) { pg8::Gemm g{H, WIN, MT, DIN, DM, DM, DM, 128, 128}; pg8::StaticOrder S; S.init(MT, DIN, G, bx);
        EpiWin E{ws, STATS, a.in[14], a.in[15], ROPE, out};
        pg8::gemm_phase(lds, g, S, E);
        const int rem = S.nwg % G;
        if (rem == 0) transpose_w13(a.in[25], a.in[26], W13B, (LAS float*)(lds + wave * 8448), gw, NGW, lane, W13_SPLIT, 2 * IT_FFN13);
        else if (bx >= rem) transpose_w13(a.in[25], a.in[26], W13B, (LAS float*)(lds + wave * 8448), (bx - rem) * NWAVES + wave, (G - rem) * NWAVES, lane, W13_SPLIT, 2 * IT_FFN13); }
    SEAM(5);
    if (IN(6)) REPS(6) {
        attn_prompt_loop(lds, a, bx, G);
        spatial_prompt_loop(lds, a, bx, G);
        for (int it = G - 1 - bx; it < 96; it += G) {
            if (it < 32) attn_unit(lds, a, 0, 0, it & 3, it >> 2);
            else spatial_unit(lds, a, MP + ((it - 32) >> 3) * 32, 32, it & 7, (it - 32) >> 3);
        }
        __syncthreads();
    }
    SEAM(6);
    if (IN(7)) REPS(7) {
        bf16_t* AO = (bf16_t*)(ws + WS_AO); bf16_t* Y = (bf16_t*)(ws + WS_Y);
        skinny_merge(AO, WPAB, (const bf16_t*)(ws + WS_GA), (const bf16_t*)(ws + WS_GB), Y, bx, G);
        pg8::Gemm g{AO, WPAB, MP, DM, 2048, 2048, 2048, 128, 128}; pg8::StaticOrder S; S.init(MP, DM, G, bx, 4); EpiMergeF E{(const bf16_t*)(ws + WS_GA), (const bf16_t*)(ws + WS_GB), Y}; pg8::gemm_phase(lds, g, S, E);
    }
    SEAM(7);
    if (IN(8)) REPS(8) { skinny_resid<true, true>((bf16_t*)(ws + WS_Y), DM, 64, WO, DM, 64, DM, X1b + (size_t)MP * DM, X2b + (size_t)MP * DM, MOD + 1 * 3 * DM + 2 * DM, 1.0f, bx, G);
        pg8::Gemm g{(bf16_t*)(ws + WS_Y), WO, MP, DM, DM, DM, DM, 128, 128}; pg8::StaticOrder S; S.init(MP, DM, G, bx, 4); EpiResid<true, true> E{X1b, nullptr, X2b, MOD + 1 * 3 * DM + 2 * DM, 1.0f}; pg8::gemm_phase(lds, g, S, E); }
    SEAM(8);
    if (IN(9)) REPS(9) norm_phase<true>(X2b, nullptr, a.in[24], MOD, 2, H, gw, NGW, lane);
    SEAM(9);
    if (IN(10)) REPS(10) { pg8::Gemm g{H, W13B, MT, 2 * DFF, DM, DM, DM, 128, 128}; pg8::StaticOrder S; S.init(MT, 2 * DFF, G, bx); EpiSwiGLU E{Gb}; pg8::gemm_phase(lds, g, S, E);
        const int rem = S.nwg % G;
        if (rem == 0) transpose_w2(a.in[27], W2B, (LAS float*)(lds + wave * 8448), gw, NGW, lane);
        else if (bx >= rem) transpose_w2(a.in[27], W2B, (LAS float*)(lds + wave * 8448), (bx - rem) * NWAVES + wave, (G - rem) * NWAVES, lane); }
    SEAM(10);
    if (IN(11)) { skinny_resid<true, false>(Gb, 64, (size_t)MT * 64, W2B, 64, (size_t)DM * 64, DFF, X2b + (size_t)MP * DM, out + O_Y + (size_t)MP * DM, MOD + 2 * 3 * DM + 2 * DM, 0.5f, bx, G);
        pg8::Gemm g{Gb, W2B, MP, DM, DFF, 64, 64, (size_t)MT * 128, (size_t)DM * 128}; pg8::StaticOrder S; S.init(MP, DM, G, bx, 4); EpiResid<true, false> E{X2b, nullptr, out + O_Y, MOD + 2 * 3 * DM + 2 * DM, 0.5f}; pg8::gemm_phase(lds, g, S, E); }
#undef IN
#undef SEAM
}

extern "C" void kernel_launch(void* const* d_in, const int* in_sizes, int n_in, void* d_out, int out_size, void* d_ws, size_t ws_size, hipStream_t stream) {
    static int grid = 0;
    if (grid == 0) {
        if (n_in != 28 || (size_t)out_size != O_END || ws_size < 1024 * MiB) { fprintf(stderr, "kernel_launch: unexpected shapes: n_in %d out %d ws %zu\n", n_in, out_size, ws_size); grid = -1; return; }
        int dev = 0, cus = 0, per_cu = 0;
        if (hipGetDevice(&dev) != hipSuccess || hipDeviceGetAttribute(&cus, hipDeviceAttributeMultiprocessorCount, dev) != hipSuccess) { grid = -1; return; }
        if (hipFuncSetAttribute((const void*)fwd_kernel, hipFuncAttributeMaxDynamicSharedMemorySize, LDS_BYTES) != hipSuccess) { fprintf(stderr, "kernel_launch: hipFuncSetAttribute failed\n"); grid = -1; return; }
        if (hipOccupancyMaxActiveBlocksPerMultiprocessor(&per_cu, (const void*)fwd_kernel, NTHR, LDS_BYTES) != hipSuccess || per_cu < 1) { fprintf(stderr, "kernel_launch: occupancy query says %d\n", per_cu); per_cu = 1; }
        (void)hipGetLastError();
        grid = cus * 1;
        fprintf(stderr, "kernel_launch: grid %d (cus %d, per_cu %d)\n", grid, cus, per_cu);
    }
    if (grid < 0) return;
    if (hipMemsetAsync(d_ws, 0, 65536, stream) != hipSuccess) { fprintf(stderr, "kernel_launch: memset failed\n"); return; }
    Args a{};
    for (int i = 0; i < 28; ++i) a.in[i] = (const float*)d_in[i];
    a.out = (float*)d_out; a.ws = (unsigned char*)d_ws;
#if MK_N_LAUNCHES == 1
    a.ph_lo = 0; a.ph_hi = 12;
    void* args[] = {&a};
    hipError_t e = hipLaunchCooperativeKernel((const void*)fwd_kernel, dim3(grid), dim3(NTHR), args, LDS_BYTES, stream);
    if (e != hipSuccess) fprintf(stderr, "kernel_launch: cooperative launch failed: %s (grid %d)\n", hipGetErrorString(e), grid);
#else
    for (int p = 0; p < 12; ++p) { a.ph_lo = p; a.ph_hi = p + 1; hipLaunchKernelGGL(fwd_kernel, dim3(grid), dim3(NTHR), LDS_BYTES, stream, a); }
#endif
}
```

```cpp
#include <hip/hip_runtime.h>
#include <hip/hip_cooperative_groups.h>
#include <cstdio>
#include <cstdint>
namespace cg = cooperative_groups;

#ifndef MK_N_LAUNCHES
#define MK_N_LAUNCHES 1
#endif
#ifndef REPMASK
#define REPMASK 0
#endif
#define REPS(k) for (int rep_ = 0; rep_ <= ((REPMASK >> (k)) & 1); ++rep_)

namespace pg8 {
#define PG8_LAS __attribute__((address_space(3)))
typedef unsigned short bf16_t;
typedef short bf16x8 __attribute__((ext_vector_type(8)));
typedef float f32x4 __attribute__((ext_vector_type(4)));
typedef float f32x2 __attribute__((ext_vector_type(2)));
typedef unsigned u32x4 __attribute__((ext_vector_type(4)));
typedef unsigned u32x2 __attribute__((ext_vector_type(2)));
constexpr int BM = 256, BK = 64, HALF = 128, HTB = HALF * BK * 2, STAGE_BYTES = 8 * HTB, NXCD = 8, WGM = 8;

__host__ __device__ __forceinline__ int lds_byte(int r, int c) { const int st = (r >> 4) * 2 + (c >> 5), rr = r & 15, cc = c & 31, ob = rr * 64 + cc * 2; return st * 1024 + (ob ^ (((ob >> 9) & 1) << 5)); }
__host__ __device__ __forceinline__ void stage_rc(int b, int& R, int& C) { const int st = b / 1024, sb = b % 1024, swz = sb ^ (((sb >> 9) & 1) << 5); R = (st >> 1) * 16 + swz / 64; C = (st & 1) * 32 + (swz % 64) / 2; }
__host__ __device__ __forceinline__ int perm32(int rho) { const int n = rho >> 4, i = rho & 15; return 8 * (i >> 2) + 4 * n + (i & 3); }

struct Unit { int pm, pn; };
struct Gemm { const bf16_t* A; const bf16_t* Bt; int M, N, K, lda, ldb; size_t kstepA, kstepB; };

struct StaticOrder {
    int nM, nN, nwg, G, c, wgm;
    __host__ __device__ void init(int M, int N, int G_, int c_, int wgm_ = WGM) { nM = M / BM; nN = N / BM; nwg = nM * nN; G = G_; c = c_; wgm = wgm_; }
    __host__ __device__ bool next(int i, Unit& u) const {
        const long L = (long)i * G + c; if (L >= nwg) return false;
        int wgid = (int)L; { const int q = nwg / NXCD, r = nwg % NXCD, xcd = wgid % NXCD, off = wgid / NXCD; wgid = (xcd < r ? xcd * (q + 1) : r * (q + 1) + (xcd - r) * q) + off; }
        const int nig = wgm * nN, gid = wgid / nig, fm = gid * wgm, gsz = (nM - fm) < wgm ? (nM - fm) : wgm;
        u.pm = fm + ((wgid % nig) % gsz); u.pn = (wgid % nig) / gsz; return true;
    }
};

__device__ __forceinline__ unsigned cvt_pk_bf16(float lo, float hi) { unsigned r; asm volatile("v_cvt_pk_bf16_f32 %0, %1, %2" : "=v"(r) : "v"(lo), "v"(hi)); return r; }
__device__ __forceinline__ f32x2 gelu_pk(f32x2 v) {
    const f32x2 av = __builtin_elementwise_abs(v), d = av * 0.2316418882f + 1.0f;
    f32x2 t; t.x = __builtin_amdgcn_rcpf(d.x); t.y = __builtin_amdgcn_rcpf(d.y);
    f32x2 q = t * 0.5307027145f + (-0.7265760135f); q = q * t + 0.7107068705f; q = q * t + (-0.142248368f); q = q * t + 0.127414796f; q = q * t;
    const f32x2 s = (v * v) * (-0.72134752044f);
    f32x2 e; e.x = __builtin_amdgcn_exp2f(s.x); e.y = __builtin_amdgcn_exp2f(s.y);
    const f32x2 m = v * (q * e), r = v - m;
    f32x2 o; o.x = v.x < 0.f ? m.x : r.x; o.y = v.y < 0.f ? m.y : r.y; return o;
}
__device__ __forceinline__ f32x4 gelu4(f32x4 v) { const f32x2 a = gelu_pk((f32x2){v[0], v[1]}), b = gelu_pk((f32x2){v[2], v[3]}); return (f32x4){a.x, a.y, b.x, b.y}; }

template <class Epi, class Sched>
__device__ __forceinline__ void gemm_phase(PG8_LAS unsigned char* lds, const Gemm g, const Sched& S, const Epi& E) {
    const int tid = threadIdx.x, wid = __builtin_amdgcn_readfirstlane(tid >> 6), lane = tid & 63, wr = wid >> 2, wc = wid & 3, fr = lane & 15, fq = lane >> 4;
    const int K = g.K, nt = K / BK;
    unsigned voffA[2], voffB[2];
#pragma unroll
    for (int i = 0; i < 2; ++i) { int R, C; stage_rc(tid * 16 + i * 8192, R, C); const int Rb = Epi::PERM ? ((R & ~31) + perm32(R & 31)) : R;
        voffA[i] = (unsigned)(R * g.lda + C) * 2u; voffB[i] = (unsigned)(Rb * g.ldb + C) * 2u; }
    const size_t kstepA = g.kstepA, kstepB = g.kstepB;
    const size_t hstepA = (size_t)HALF * g.lda * 2, hstepB = (size_t)HALF * g.ldb * 2;
    const size_t tstepA = 2 * hstepA, tstepB = 2 * hstepB;
    const unsigned ldsw = (unsigned)wid * 1024u;
    const int aoff = lds_byte(wr * 64 + fr, fq * 8), boff = lds_byte(wc * 32 + fr, fq * 8);
#define PG8_SA(b, h) (((b) * 2 + (h)) * HTB)
#define PG8_SB(b, h) ((4 + (b) * 2 + (h)) * HTB)
#define PG8_STAGE(bufoff, gbase, voff) do { _Pragma("unroll") for (int _i = 0; _i < 2; ++_i) \
        __builtin_amdgcn_global_load_lds((const unsigned*)((const char*)(gbase) + (voff)[_i]), (PG8_LAS unsigned*)(lds + (bufoff) + ldsw + _i * 8192), 16, 0, 0); } while (0)
#define PG8_LDA(dst, b, h) do { _Pragma("unroll") for (int m = 0; m < 4; ++m) _Pragma("unroll") for (int k = 0; k < 2; ++k) dst[m][k] = *(const PG8_LAS bf16x8*)(lds + PG8_SA(b, h) + aoff + m * 2048 + k * 1024); } while (0)
#define PG8_LDB(dst, b, h) do { _Pragma("unroll") for (int n = 0; n < 2; ++n) _Pragma("unroll") for (int k = 0; k < 2; ++k) dst[n][k] = *(const PG8_LAS bf16x8*)(lds + PG8_SB(b, h) + boff + n * 2048 + k * 1024); } while (0)
#define PG8_MMA(ai, bj, At, Bt) do { __builtin_amdgcn_s_setprio(1); _Pragma("unroll") for (int m = 0; m < 4; ++m) _Pragma("unroll") for (int n = 0; n < 2; ++n) _Pragma("unroll") for (int k = 0; k < 2; ++k) \
        acc[ai][bj][m][n] = __builtin_amdgcn_mfma_f32_16x16x32_bf16(Bt[n][k], At[m][k], acc[ai][bj][m][n], 0, 0, 0); __builtin_amdgcn_s_setprio(0); } while (0)
#define PG8_WAIT_V(n) asm volatile("s_waitcnt vmcnt(" #n ")" ::: "memory")
#define PG8_WAIT_L(n) asm volatile("s_waitcnt lgkmcnt(" #n ")" ::: "memory")
#define PG8_BAR __builtin_amdgcn_s_barrier()
#define PG8_SCHED __builtin_amdgcn_sched_barrier(0)
    Unit cur, nxt; int ui = 0;
    if (!S.next(0, cur)) return;
    f32x4 acc[2][2][4][2];
#pragma unroll
    for (int a = 0; a < 2; ++a)
#pragma unroll
        for (int b = 0; b < 2; ++b)
#pragma unroll
            for (int m = 0; m < 4; ++m)
#pragma unroll
                for (int n = 0; n < 2; ++n) acc[a][b][m][n] = (f32x4){0.f, 0.f, 0.f, 0.f};
    bf16x8 At[4][2], B0[2][2], B1[2][2];
    const char* cA = (const char*)g.A + (size_t)cur.pm * tstepA; const char* cB = (const char*)g.Bt + (size_t)cur.pn * tstepB;
    PG8_STAGE(PG8_SB(0, 0), cB, voffB); PG8_STAGE(PG8_SB(0, 1), cB + hstepB, voffB); PG8_STAGE(PG8_SA(0, 0), cA, voffA); PG8_STAGE(PG8_SA(0, 1), cA + hstepA, voffA);
    if (wr == 1) PG8_BAR;
    PG8_WAIT_V(2); PG8_BAR;
    PG8_STAGE(PG8_SB(1, 0), cB + kstepB, voffB); PG8_STAGE(PG8_SA(1, 0), cA + kstepA, voffA); PG8_STAGE(PG8_SB(1, 1), cB + hstepB + kstepB, voffB);
    PG8_WAIT_V(6); PG8_BAR;
    for (;;) {
        const bool has_next = S.next(ui + 1, nxt);
        const char* nA = has_next ? (const char*)g.A + (size_t)nxt.pm * tstepA : cA; const char* nB = has_next ? (const char*)g.Bt + (size_t)nxt.pn * tstepB : cB;
        for (int t = 0; t < nt; t += 2) {
            if constexpr (Epi::HAS_MID) { if (t == Epi::MID_T) E.mid(acc, cur, wr, wc, fr, fq); }
            const bool last = (t == nt - 2);
            const char* a1 = cA + (size_t)(t + 1) * kstepA;
            const char* a2 = last ? nA : cA + (size_t)(t + 2) * kstepA; const char* b2 = last ? nB : cB + (size_t)(t + 2) * kstepB;
            const char* a3 = a2 + kstepA; const char* b3 = b2 + kstepB;
            PG8_LDB(B0, 0, 0); PG8_LDB(B1, 0, 1); PG8_SCHED; PG8_LDA(At, 0, 0); PG8_STAGE(PG8_SA(1, 1), a1 + hstepA, voffA);
            PG8_WAIT_V(8); PG8_WAIT_L(0); PG8_BAR; PG8_MMA(0, 0, At, B0); PG8_MMA(0, 1, At, B1); PG8_BAR; PG8_SCHED;
            PG8_LDA(At, 0, 1); PG8_STAGE(PG8_SB(0, 0), b2, voffB); PG8_STAGE(PG8_SB(0, 1), b2 + hstepB, voffB); PG8_STAGE(PG8_SA(0, 0), a2, voffA);
            PG8_WAIT_V(8); PG8_WAIT_L(0); PG8_BAR; PG8_MMA(1, 0, At, B0); PG8_MMA(1, 1, At, B1); PG8_BAR; PG8_SCHED;
            PG8_LDB(B0, 1, 0); PG8_LDB(B1, 1, 1); PG8_SCHED; PG8_LDA(At, 1, 0); PG8_STAGE(PG8_SA(0, 1), a2 + hstepA, voffA);
            PG8_WAIT_V(8); PG8_WAIT_L(0); PG8_BAR; PG8_MMA(0, 0, At, B0); PG8_MMA(0, 1, At, B1); PG8_BAR; PG8_SCHED;
            PG8_LDA(At, 1, 1); PG8_STAGE(PG8_SB(1, 0), b3, voffB); PG8_STAGE(PG8_SB(1, 1), b3 + hstepB, voffB); PG8_STAGE(PG8_SA(1, 0), a3, voffA);
            PG8_WAIT_V(8); PG8_WAIT_L(0); PG8_BAR; PG8_MMA(1, 0, At, B0); PG8_MMA(1, 1, At, B1); PG8_BAR; PG8_SCHED;
        }
        if (wr == 0) PG8_BAR;
        E(acc, cur, wr, wc, fr, fq);
        if (!has_next) break;
#pragma unroll
        for (int a = 0; a < 2; ++a)
#pragma unroll
            for (int b = 0; b < 2; ++b)
#pragma unroll
                for (int m = 0; m < 4; ++m)
#pragma unroll
                    for (int n = 0; n < 2; ++n) acc[a][b][m][n] = (f32x4){0.f, 0.f, 0.f, 0.f};
        cur = nxt; cA = nA; cB = nB; ++ui;
        if (wr == 1) PG8_BAR;
    }
    PG8_WAIT_V(0);
    PG8_BAR;
#undef PG8_SA
#undef PG8_SB
#undef PG8_STAGE
#undef PG8_LDA
#undef PG8_LDB
#undef PG8_MMA
#undef PG8_WAIT_V
#undef PG8_WAIT_L
#undef PG8_BAR
#undef PG8_SCHED
}
}

using pg8::bf16_t; using pg8::bf16x8; using pg8::f32x4; using pg8::f32x2; using pg8::u32x4; using pg8::u32x2; using pg8::cvt_pk_bf16; using pg8::Unit;
#define LAS __attribute__((address_space(3)))

constexpr int DM = 2048, DFF = 5632, DA = 1024, DB = 1024, DKV = 256, DIN = 7680;
constexpr int MP = 32768, MS = 256, MT = MP + MS, SEQ = 8192;
constexpr int MODW = 18432;
constexpr float EPS = 1e-6f;
constexpr int NWAVES = 8, NTHR = 512;
constexpr int LDS_BYTES = 147456;

constexpr size_t O_Y = 0, O_KP = (size_t)MT * DM, O_VP = O_KP + 131072, O_KS = O_VP + 131072, O_VS = O_KS + 262144, O_GV = O_VS + 262144, O_END = O_GV + 262144;

constexpr size_t MiB = 1u << 20;
constexpr size_t WS_MOD = 1 * MiB, WS_ROPE = 2 * MiB, WS_STATS = 3 * MiB;
constexpr size_t WS_W13 = 8 * MiB, WS_W2 = 52 * MiB, WS_WIN = 74 * MiB, WS_WPAB = 104 * MiB, WS_WO = 112 * MiB;
constexpr size_t WS_X1 = 120 * MiB, WS_H = 378 * MiB, WS_G = 507 * MiB;
constexpr size_t SZ_M1024 = (size_t)MT * 1024 * 2, SZ_M256 = (size_t)MT * 256 * 2, SZ_M2048 = (size_t)MT * 2048 * 2;
constexpr size_t WS_U = WS_G, WS_GV = WS_U + SZ_M1024, WS_Q = WS_GV + SZ_M1024, WS_K = WS_Q + SZ_M1024, WS_V = WS_K + SZ_M256, WS_GA = WS_V + SZ_M256, WS_GB = WS_GA + SZ_M2048, WS_END = WS_GB + SZ_M2048;
constexpr size_t WS_W2B = 992 * MiB;
static_assert(WS_END <= WS_W2B && WS_W2B + (size_t)DM * DFF * 2 <= 1024 * MiB, "W2B");
constexpr size_t WS_Y = WS_U;
constexpr size_t WS_AO = WS_H;
static_assert(WS_G + (size_t)MT * DFF * 2 <= 1024 * MiB && WS_END <= 1024 * MiB, "workspace map");
static_assert(WS_STATS + (size_t)MT * 16 * 8 <= WS_W13, "stats");

struct Args { const float* in[28]; float* out; unsigned char* ws; int ph_lo, ph_hi; };

__device__ __forceinline__ int mrow(int row) { return row < MP ? (row >> 13) : 4 + ((row - MP) >> 5); }
__device__ __forceinline__ float bf_lo(unsigned w) { return __uint_as_float(w << 16); }
__device__ __forceinline__ float bf_hi(unsigned w) { return __uint_as_float(w & 0xffff0000u); }
__device__ __forceinline__ float wave_sum(float v) {
#pragma unroll
    for (int o = 1; o < 64; o <<= 1) v += __shfl_xor(v, o);
    return v;
}
__device__ __forceinline__ float sigmoidf_(float x) { return __builtin_amdgcn_rcpf(1.0f + __expf(-x)); }

struct EpiSwiGLU {
    static constexpr bool PERM = true, HAS_MID = false; static constexpr int MID_T = 0;
    bf16_t* G;
    __device__ __forceinline__ void operator()(const f32x4 (&acc)[2][2][4][2], const Unit& u, int wr, int wc, int fr, int fq) const {
        const int row0 = u.pm * 256 + wr * 64 + fr, col = u.pn * 128 + wc * 32 + 8 * fq;
#pragma unroll
        for (int ai = 0; ai < 2; ++ai)
#pragma unroll
            for (int m = 0; m < 4; ++m) {
                const int row = row0 + ai * 128 + m * 16;
                f32x4 r[2];
#pragma unroll
                for (int n = 0; n < 2; ++n) { const f32x4 a = acc[ai][0][m][n], b = acc[ai][1][m][n];
#pragma unroll
                    for (int e = 0; e < 4; ++e) r[n][e] = a[e] * b[e] * sigmoidf_(a[e]); }
                u32x4 w; w.x = cvt_pk_bf16(r[0][0], r[0][1]); w.y = cvt_pk_bf16(r[0][2], r[0][3]); w.z = cvt_pk_bf16(r[1][0], r[1][1]); w.w = cvt_pk_bf16(r[1][2], r[1][3]);
                __builtin_nontemporal_store(w, (u32x4*)(G + ((size_t)(col >> 6) * MT + row) * 64 + (col & 63)));
            }
    }
};

template <bool BASE_BF16, bool OUT_BF16> struct EpiResid {
    static constexpr bool PERM = true, HAS_MID = false; static constexpr int MID_T = 0;
    const void* baseP; const void* baseS; void* out; const float* gate; float coef;
    __device__ __forceinline__ void operator()(const f32x4 (&acc)[2][2][4][2], const Unit& u, int wr, int wc, int fr, int fq) const {
        const int pm = u.pm;
        const int colb = u.pn * 256 + wc * 32 + 8 * fq;
        f32x4 gv[2][2];
#pragma unroll
        for (int bj = 0; bj < 2; ++bj)
#pragma unroll
            for (int n = 0; n < 2; ++n) gv[bj][n] = *(const f32x4*)(gate + (size_t)(pm >> 5) * MODW + colb + bj * 128 + n * 4) * coef;
#pragma unroll
        for (int ah = 0; ah < 4; ++ah) {
            const int ai = ah >> 1;
            f32x4 b[2][2][2];
#pragma unroll
            for (int mm = 0; mm < 2; ++mm) {
                const int row = pm * 256 + ai * 128 + wr * 64 + (2 * (ah & 1) + mm) * 16 + fr;
                if (BASE_BF16) {
                    const bf16_t* bp = (const bf16_t*)baseP + (size_t)row * DM + colb;
#pragma unroll
                    for (int bj = 0; bj < 2; ++bj) { const u32x4 w = __builtin_nontemporal_load((const u32x4*)(bp + bj * 128));
                        b[mm][bj][0] = (f32x4){bf_lo(w.x), bf_hi(w.x), bf_lo(w.y), bf_hi(w.y)}; b[mm][bj][1] = (f32x4){bf_lo(w.z), bf_hi(w.z), bf_lo(w.w), bf_hi(w.w)}; }
                } else {
                    const float* bp = (const float*)baseP + (size_t)row * DM + colb;
#pragma unroll
                    for (int bj = 0; bj < 2; ++bj)
#pragma unroll
                        for (int n = 0; n < 2; ++n) b[mm][bj][n] = __builtin_nontemporal_load((const f32x4*)(bp + bj * 128 + n * 4));
                }
            }
#pragma unroll
            for (int mm = 0; mm < 2; ++mm) {
                const int m = 2 * (ah & 1) + mm;
                const int row = pm * 256 + ai * 128 + wr * 64 + m * 16 + fr;
#pragma unroll
                for (int bj = 0; bj < 2; ++bj) {
                    f32x4 r[2];
#pragma unroll
                    for (int n = 0; n < 2; ++n) r[n] = b[mm][bj][n] + gv[bj][n] * acc[ai][bj][m][n];
                    if (OUT_BF16) { u32x4 w; w.x = cvt_pk_bf16(r[0][0], r[0][1]); w.y = cvt_pk_bf16(r[0][2], r[0][3]); w.z = cvt_pk_bf16(r[1][0], r[1][1]); w.w = cvt_pk_bf16(r[1][2], r[1][3]);
                        *(u32x4*)((bf16_t*)out + (size_t)row * DM + colb + bj * 128) = w; }
                    else { float* op = (float*)out + (size_t)row * DM + colb + bj * 128; __builtin_nontemporal_store(r[0], (f32x4*)op); __builtin_nontemporal_store(r[1], (f32x4*)(op + 4)); }
                }
            }
            asm volatile("" ::: "memory");
        }
    }
};

struct EpiMergeF {
    static constexpr bool PERM = true, HAS_MID = true; static constexpr int MID_T = 16;
    const bf16_t* GA; const bf16_t* GB; bf16_t* Y;
    __device__ __forceinline__ void mid(f32x4 (&acc)[2][2][4][2], const Unit& u, int wr, int wc, int fr, int fq) const {
        int rowv = u.pm * 256 + wr * 64 + fr, colv = u.pn * 256 + wc * 32 + 8 * fq;
        asm volatile("" : "+v"(rowv), "+v"(colv));
        const unsigned off0 = (unsigned)rowv * DM + (unsigned)colv;
#pragma unroll
        for (int ai = 0; ai < 2; ++ai) {
            u32x4 ga[4][2], gb[4][2];
#pragma unroll
            for (int m = 0; m < 4; ++m) { const unsigned ro = off0 + (unsigned)((ai * 128 + m * 16) * DM);
#pragma unroll
                for (int bj = 0; bj < 2; ++bj) { ga[m][bj] = __builtin_nontemporal_load((const u32x4*)(GA + ro + bj * 128)); gb[m][bj] = *(const u32x4*)(GB + ro + bj * 128); } }
#pragma unroll
            for (int m = 0; m < 4; ++m)
#pragma unroll
                for (int bj = 0; bj < 2; ++bj) { const u32x4 a = ga[m][bj], b = gb[m][bj];
                    const f32x4 a0 = (f32x4){bf_lo(a.x), bf_hi(a.x), bf_lo(a.y), bf_hi(a.y)}, a1 = (f32x4){bf_lo(a.z), bf_hi(a.z), bf_lo(a.w), bf_hi(a.w)};
                    f32x4 b0 = (f32x4){bf_lo(b.x), bf_hi(b.x), bf_lo(b.y), bf_hi(b.y)}, b1 = (f32x4){bf_lo(b.z), bf_hi(b.z), bf_lo(b.w), bf_hi(b.w)};
#pragma unroll
                    for (int e = 0; e < 4; ++e) { b0[e] = __builtin_amdgcn_rcpf(fmaxf(b0[e], 1e-30f)); b1[e] = __builtin_amdgcn_rcpf(fmaxf(b1[e], 1e-30f)); }
                    acc[ai][bj][m][0] *= a0 * b0; acc[ai][bj][m][1] *= a1 * b1; }
            asm volatile("" ::: "memory");
        }
    }
    __device__ __forceinline__ void operator()(const f32x4 (&acc)[2][2][4][2], const Unit& u, int wr, int wc, int fr, int fq) const {
        const int colb = u.pn * 256 + wc * 32 + 8 * fq;
#pragma unroll
        for (int ai = 0; ai < 2; ++ai) {
            u32x4 gb[4][2];
#pragma unroll
            for (int m = 0; m < 4; ++m) { const size_t ro = (size_t)(u.pm * 256 + ai * 128 + wr * 64 + m * 16 + fr) * DM + colb;
#pragma unroll
                for (int bj = 0; bj < 2; ++bj) gb[m][bj] = *(const u32x4*)(GB + ro + bj * 128); }
#pragma unroll
            for (int m = 0; m < 4; ++m) { const size_t ro = (size_t)(u.pm * 256 + ai * 128 + wr * 64 + m * 16 + fr) * DM + colb;
#pragma unroll
                for (int bj = 0; bj < 2; ++bj) { const u32x4 b = gb[m][bj];
                    const f32x4 r0 = acc[ai][bj][m][0] * (f32x4){bf_lo(b.x), bf_hi(b.x), bf_lo(b.y), bf_hi(b.y)}, r1 = acc[ai][bj][m][1] * (f32x4){bf_lo(b.z), bf_hi(b.z), bf_lo(b.w), bf_hi(b.w)};
                    u32x4 w; w.x = cvt_pk_bf16(r0[0], r0[1]); w.y = cvt_pk_bf16(r0[2], r0[3]); w.z = cvt_pk_bf16(r1[0], r1[1]); w.w = cvt_pk_bf16(r1[2], r1[3]);
                    *(u32x4*)(Y + ro + bj * 128) = w; } }
            asm volatile("" ::: "memory");
        }
    }
};

struct EpiWin {
    static constexpr bool PERM = true, HAS_MID = false; static constexpr int MID_T = 0;
    unsigned char* ws; f32x2* stats; const float* gq; const float* gk; const f32x2* rope; float* out;
    __device__ __forceinline__ void operator()(const f32x4 (&acc)[2][2][4][2], const Unit& u, int wr, int wc, int fr, int fq) const {
        const int pn = u.pn, row0 = u.pm * 256 + wr * 64 + fr, cw = wc * 32 + 8 * fq;
        if (pn < 8) {
            bf16_t* dst = (bf16_t*)(ws + WS_U + (pn < 4 ? (size_t)0 : SZ_M1024)) + (pn & 3) * 256 + cw;
#pragma unroll
            for (int ai = 0; ai < 2; ++ai)
#pragma unroll
                for (int m = 0; m < 4; ++m) {
                    const int row = row0 + ai * 128 + m * 16; float s1 = 0.f, s2 = 0.f;
#pragma unroll
                    for (int bj = 0; bj < 2; ++bj) {
                        const f32x4 v0 = pg8::gelu4(acc[ai][bj][m][0]), v1 = pg8::gelu4(acc[ai][bj][m][1]);
                        s1 += (v0[0] + v0[1]) + (v0[2] + v0[3]) + (v1[0] + v1[1]) + (v1[2] + v1[3]);
                        s2 += (v0[0] * v0[0] + v0[1] * v0[1]) + (v0[2] * v0[2] + v0[3] * v0[3]) + (v1[0] * v1[0] + v1[1] * v1[1]) + (v1[2] * v1[2] + v1[3] * v1[3]);
                        u32x4 w; w.x = cvt_pk_bf16(v0[0], v0[1]); w.y = cvt_pk_bf16(v0[2], v0[3]); w.z = cvt_pk_bf16(v1[0], v1[1]); w.w = cvt_pk_bf16(v1[2], v1[3]);
                        __builtin_nontemporal_store(w, (u32x4*)(dst + (size_t)row * 1024 + bj * 128));
                    }
                    if (pn >= 4) {
                        s1 += __shfl_xor(s1, 16); s1 += __shfl_xor(s1, 32); s2 += __shfl_xor(s2, 16); s2 += __shfl_xor(s2, 32);
                        if (fq == 0) stats[(size_t)row * 16 + (pn - 4) * 4 + wc] = (f32x2){s1, s2};
                    }
                }
        } else if (pn < 14) {
            const int t = pn - 8; const bool isq = t < 4, isk = t == 4, isv = t == 5;
            const float* gvec = isq ? gq : gk;
            f32x4 gg[2][2];
#pragma unroll
            for (int bj = 0; bj < 2; ++bj)
#pragma unroll
                for (int n = 0; n < 2; ++n) gg[bj][n] = *(const f32x4*)(gvec + 32 * bj + 8 * fq + 4 * n);
#pragma unroll
            for (int ai = 0; ai < 2; ++ai)
#pragma unroll
                for (int m = 0; m < 4; ++m) {
                    const int row = row0 + ai * 128 + m * 16;
                    f32x4 x[2][2];
#pragma unroll
                    for (int bj = 0; bj < 2; ++bj)
#pragma unroll
                        for (int n = 0; n < 2; ++n) x[bj][n] = acc[ai][bj][m][n];
                    if (!isv) {
                        float ss = 0.f;
#pragma unroll
                        for (int bj = 0; bj < 2; ++bj)
#pragma unroll
                            for (int n = 0; n < 2; ++n) ss += (x[bj][n][0] * x[bj][n][0] + x[bj][n][1] * x[bj][n][1]) + (x[bj][n][2] * x[bj][n][2] + x[bj][n][3] * x[bj][n][3]);
                        ss += __shfl_xor(ss, 16); ss += __shfl_xor(ss, 32);
                        const float rstd = rsqrtf(ss * (1.0f / 64.0f) + EPS);
#pragma unroll
                        for (int bj = 0; bj < 2; ++bj)
#pragma unroll
                            for (int n = 0; n < 2; ++n) x[bj][n] = x[bj][n] * rstd * gg[bj][n];
                        const int pos = row < MP ? (row & (SEQ - 1)) : 2048 + ((row - MP) & 31);
                        f32x4 pr[2];
#pragma unroll
                        for (int n = 0; n < 2; ++n)
#pragma unroll
                            for (int e = 0; e < 4; ++e) pr[n][e] = __shfl_xor(x[0][n][e], 16);
                        if (fq < 2) {
                            const float sgn = fq == 0 ? -1.0f : 1.0f;
#pragma unroll
                            for (int n = 0; n < 2; ++n) {
                                const f32x4 c01 = *(const f32x4*)(rope + (size_t)pos * 8 + 4 * n), c23 = *(const f32x4*)(rope + (size_t)pos * 8 + 4 * n + 2);
                                x[0][n][0] = x[0][n][0] * c01[0] + sgn * pr[n][0] * c01[1];
                                x[0][n][1] = x[0][n][1] * c01[2] + sgn * pr[n][1] * c01[3];
                                x[0][n][2] = x[0][n][2] * c23[0] + sgn * pr[n][2] * c23[1];
                                x[0][n][3] = x[0][n][3] * c23[2] + sgn * pr[n][3] * c23[3];
                            }
                        }
                    }
                    bf16_t* dst = isq ? (bf16_t*)(ws + WS_Q) + (size_t)row * 1024 + (4 * t + wc) * 64 : (bf16_t*)(ws + WS_K + (isk ? (size_t)0 : SZ_M256)) + (size_t)row * 256 + wc * 64;
#pragma unroll
                    for (int bj = 0; bj < 2; ++bj) {
                        u32x4 w; w.x = cvt_pk_bf16(x[bj][0][0], x[bj][0][1]); w.y = cvt_pk_bf16(x[bj][0][2], x[bj][0][3]); w.z = cvt_pk_bf16(x[bj][1][0], x[bj][1][1]); w.w = cvt_pk_bf16(x[bj][1][2], x[bj][1][3]);
                        *(u32x4*)(dst + 32 * bj + 8 * fq) = w;
                    }
                    if (!isq) {
                        float* o = nullptr;
                        if (row < MP) { const int tp = row & (SEQ - 1); if (tp >= SEQ - 128) o = out + (isk ? O_KP : O_VP) + ((size_t)((row >> 13) * 128 + tp - (SEQ - 128)) * 4 + wc) * 64; }
                        else { const int j = (row - MP) & 31, b = (row - MP) >> 5; o = out + (isk ? O_KS : O_VS) + ((size_t)(b * 128 + 96 + j) * 4 + wc) * 64; }
                        if (o) {
#pragma unroll
                            for (int bj = 0; bj < 2; ++bj)
#pragma unroll
                                for (int n = 0; n < 2; ++n) *(f32x4*)(o + 32 * bj + 8 * fq + 4 * n) = x[bj][n];
                        }
                    }
                }
        } else {
            bf16_t* dst = (bf16_t*)(ws + WS_GA + (pn < 22 ? (size_t)0 : SZ_M2048)) + ((pn - 14) & 7) * 256 + cw;
#pragma unroll
            for (int ai = 0; ai < 2; ++ai)
#pragma unroll
                for (int m = 0; m < 4; ++m) {
                    const int row = row0 + ai * 128 + m * 16;
#pragma unroll
                    for (int bj = 0; bj < 2; ++bj) {
                        f32x4 v0 = acc[ai][bj][m][0], v1 = acc[ai][bj][m][1];
#pragma unroll
                        for (int e = 0; e < 4; ++e) { v0[e] = sigmoidf_(v0[e]); v1[e] = sigmoidf_(v1[e]); }
                        u32x4 w; w.x = cvt_pk_bf16(v0[0], v0[1]); w.y = cvt_pk_bf16(v0[2], v0[3]); w.z = cvt_pk_bf16(v1[0], v1[1]); w.w = cvt_pk_bf16(v1[2], v1[3]);
                        __builtin_nontemporal_store(w, (u32x4*)(dst + (size_t)row * 2048 + bj * 128));
                    }
                }
        }
    }
};

__device__ __forceinline__ void transpose_item(const float* W, int N, int k0, int n0, bf16_t* dst  , int ld, LAS float* scr, int lane) {
#pragma unroll 8
    for (int i = 0; i < 32; ++i) { const int kk = 2 * i + (lane >> 5); scr[kk * 33 + (lane & 31)] = __builtin_nontemporal_load(W + (size_t)(k0 + kk) * N + n0 + (lane & 31)); }
    asm volatile("s_waitcnt lgkmcnt(0)" ::: "memory");
    const int c = lane & 7;
#pragma unroll
    for (int j = 0; j < 4; ++j) { const int n = (lane >> 3) + 8 * j; const LAS float* s = scr + (8 * c) * 33 + n;
        u32x4 o; o.x = cvt_pk_bf16(s[0 * 33], s[1 * 33]); o.y = cvt_pk_bf16(s[2 * 33], s[3 * 33]); o.z = cvt_pk_bf16(s[4 * 33], s[5 * 33]); o.w = cvt_pk_bf16(s[6 * 33], s[7 * 33]);
        *(u32x4*)(dst + (size_t)n * ld + 8 * c) = o; }
    asm volatile("s_waitcnt lgkmcnt(0)" ::: "memory");
}
__device__ __forceinline__ void tr_mat(int r, const float* W, int K, int N, bf16_t* dst, int ld, int coff, int kind, LAS float* scr, int lane) {
    const int nblk = N / 32, kb = r / nblk, nb = r - kb * nblk, k0 = 64 * kb, n0 = 32 * nb;
    int drow = n0;
    if (kind == 1) drow = 256 * (n0 >> 7) + (n0 & 127);
    else if (kind == 2) drow = 256 * (n0 >> 7) + 128 + (n0 & 127);
    else if (kind == 3) { if (n0 >= 2048 && n0 < 3584) { const int t = n0 - 2048, tile = t >> 8, o = t & 255; drow = 2048 + 256 * tile + 128 * ((o >> 5) & 1) + 32 * (o >> 6); } }
    transpose_item(W, N, k0, n0, dst + (size_t)drow * ld + coff + k0, ld, scr, lane);
}
constexpr int W13_SPLIT = (2 * (DM / 64) * (DFF / 32)) * 3 / 5;
constexpr int IT_FFN13 = (DM / 64) * (DFF / 32), IT_FFN2 = (DFF / 64) * (DM / 32), IT_WIN = (DM / 64) * (DIN / 32), IT_WP = (DA / 64) * (DM / 32), IT_WO = (DM / 64) * (DM / 32);
__device__ __forceinline__ void transpose_w13(const float* w1, const float* w3, bf16_t* dst, LAS float* scr, int gw, int NGW, int lane, int lo = 0, int hi = 2 * IT_FFN13) {
    for (int it = lo + gw; it < hi; it += NGW) {
        if (it < IT_FFN13) tr_mat(it, w1, DM, DFF, dst, DM, 0, 1, scr, lane);
        else tr_mat(it - IT_FFN13, w3, DM, DFF, dst, DM, 0, 2, scr, lane);
    }
}
__device__ __forceinline__ void transpose_w2(const float* w2, bf16_t* dst, LAS float* scr, int gw, int NGW, int lane) {
    for (int r = gw; r < IT_FFN2; r += NGW) { const int nblk = DM / 32, kb = r / nblk, nb = r - kb * nblk; transpose_item(w2, DM, 64 * kb, 32 * nb, dst + ((size_t)kb * DM + 32 * nb) * 64, 64, scr, lane); }
}

__device__ __forceinline__ void transpose_wpo(const float* wpa, const float* wpb, const float* wo, bf16_t* WPAB, bf16_t* WO, LAS float* scr, int gw, int NGW, int lane) {
    for (int it = gw; it < 2 * IT_WP + IT_WO; it += NGW) {
        int r = it;
        if (r < IT_WP) { tr_mat(r, wpa, DA, DM, WPAB, 2048, 0, 0, scr, lane); continue; } r -= IT_WP;
        if (r < IT_WP) { tr_mat(r, wpb, DB, DM, WPAB, 2048, 1024, 0, scr, lane); continue; } r -= IT_WP;
        tr_mat(r, wo, DM, DM, WO, DM, 0, 0, scr, lane);
    }
}

template <bool SRC_BF16>
__device__ __forceinline__ void load_row(const void* srcP, const void* srcS, int r, int lane, f32x4 (&v)[8]) {
    if (SRC_BF16) { const u32x2* xr = (const u32x2*)((const bf16_t*)srcP + (size_t)r * DM) + lane;
#pragma unroll
        for (int j = 0; j < 8; ++j) { const u32x2 w = __builtin_nontemporal_load(xr + 64 * j); v[j] = (f32x4){bf_lo(w.x), bf_hi(w.x), bf_lo(w.y), bf_hi(w.y)}; } }
    else { const f32x4* xr = (const f32x4*)(r < MP ? (const float*)srcP + (size_t)r * DM : (const float*)srcS + (size_t)(r - MP) * DM) + lane;
#pragma unroll
        for (int j = 0; j < 8; ++j) v[j] = __builtin_nontemporal_load(xr + 64 * j); }
}
template <bool SRC_BF16>
__device__ __forceinline__ void norm_phase(const void* srcP, const void* srcS, const float* g, const float* mod, int sub, bf16_t* H, int gw, int NGW, int lane) {
    const int R = (MT + NGW - 1) / NGW, r0 = gw * R, r1 = (r0 + R < MT) ? r0 + R : MT;
    if (r0 >= r1) return;
    int cur = -1; f32x4 gs[8], sh[8], v[8], nv[8];
    load_row<SRC_BF16>(srcP, srcS, r0, lane, v);
    for (int r = r0; r < r1; ++r) {
        if (r + 1 < r1) load_row<SRC_BF16>(srcP, srcS, r + 1, lane, nv);
        const int mr = mrow(r);
        if (mr != cur) { cur = mr; const f32x4* g4 = (const f32x4*)g + lane; const f32x4* m4 = (const f32x4*)(mod + (size_t)mr * MODW + sub * 3 * DM) + lane;
#pragma unroll
            for (int j = 0; j < 8; ++j) { gs[j] = g4[64 * j] * (m4[512 + 64 * j] + 1.0f); sh[j] = m4[64 * j]; } }
        float ss = 0.f;
#pragma unroll
        for (int j = 0; j < 8; ++j) ss += (v[j][0] * v[j][0] + v[j][1] * v[j][1]) + (v[j][2] * v[j][2] + v[j][3] * v[j][3]);
        const float rstd = rsqrtf(wave_sum(ss) * (1.0f / DM) + EPS);
        u32x2* o = (u32x2*)(H + (size_t)r * DM) + lane;
#pragma unroll
        for (int j = 0; j < 8; ++j) { const f32x4 h = v[j] * rstd * gs[j] + sh[j]; u32x2 w; w.x = cvt_pk_bf16(h[0], h[1]); w.y = cvt_pk_bf16(h[2], h[3]); o[64 * j] = w; }
#pragma unroll
        for (int j = 0; j < 8; ++j) v[j] = nv[j];
    }
}

constexpr int VNT_LD = 136;
constexpr int KS_LD = 72;
constexpr int VT_LD = 200;
constexpr int VT_OFF = 192 * KS_LD * 2;

__device__ __forceinline__ void spatial_unit(LAS unsigned char* lds, const Args& a, int row0, int nrows, int g, int sb) {
    const int tid = threadIdx.x, w = __builtin_amdgcn_readfirstlane(tid >> 6), lane = tid & 63;
    unsigned char* ws = a.ws;
    const bf16_t* GV = (const bf16_t*)(ws + WS_GV); const bf16_t* U = (const bf16_t*)(ws + WS_U); bf16_t* AO = (bf16_t*)(ws + WS_AO);
    const f32x2* stats = (const f32x2*)(ws + WS_STATS);
    const float* lng = a.in[16]; const float* lnb = a.in[17]; const float* w_s = a.in[18]; const float* b_s = a.in[19];
    LAS bf16_t* vnT = (LAS bf16_t*)lds;
    __syncthreads();
    {
        const int j = tid >> 2, cq = tid & 3;
        if (j < nrows) {
            const int row = row0 + j;
            const f32x4* st = (const f32x4*)(stats + (size_t)row * 16);
            float s1 = 0.f, s2 = 0.f;
#pragma unroll
            for (int i = 0; i < 8; ++i) { const f32x4 p = st[i]; s1 += p[0] + p[2]; s2 += p[1] + p[3]; }
            const float mean = s1 * (1.0f / 1024.0f), var = s2 * (1.0f / 1024.0f) - mean * mean, rstd = rsqrtf(var + EPS);
            const u32x4* src = (const u32x4*)(GV + (size_t)row * 1024 + 128 * g + 32 * cq);
#pragma unroll
            for (int q = 0; q < 4; ++q) {
                const u32x4 pk = __builtin_nontemporal_load(src + q); const int c0 = 32 * cq + 8 * q;
                const f32x4 ga = *(const f32x4*)(lng + 128 * g + c0), gb = *(const f32x4*)(lng + 128 * g + c0 + 4), ba = *(const f32x4*)(lnb + 128 * g + c0), bb = *(const f32x4*)(lnb + 128 * g + c0 + 4);
                f32x4 x0 = (f32x4){bf_lo(pk.x), bf_hi(pk.x), bf_lo(pk.y), bf_hi(pk.y)}, x1 = (f32x4){bf_lo(pk.z), bf_hi(pk.z), bf_lo(pk.w), bf_hi(pk.w)};
                x0 = (x0 - mean) * rstd * ga + ba; x1 = (x1 - mean) * rstd * gb + bb;
                if (sb >= 0) { float* o = a.out + O_GV + (size_t)(sb * 32 + j) * 1024 + 128 * g + c0; *(f32x4*)o = x0; *(f32x4*)(o + 4) = x1; }
                const unsigned p0 = cvt_pk_bf16(x0[0], x0[1]), p1 = cvt_pk_bf16(x0[2], x0[3]), p2 = cvt_pk_bf16(x1[0], x1[1]), p3 = cvt_pk_bf16(x1[2], x1[3]);
                vnT[(c0 + 0) * VNT_LD + j] = (bf16_t)(p0 & 0xffff); vnT[(c0 + 1) * VNT_LD + j] = (bf16_t)(p0 >> 16);
                vnT[(c0 + 2) * VNT_LD + j] = (bf16_t)(p1 & 0xffff); vnT[(c0 + 3) * VNT_LD + j] = (bf16_t)(p1 >> 16);
                vnT[(c0 + 4) * VNT_LD + j] = (bf16_t)(p2 & 0xffff); vnT[(c0 + 5) * VNT_LD + j] = (bf16_t)(p2 >> 16);
                vnT[(c0 + 6) * VNT_LD + j] = (bf16_t)(p3 & 0xffff); vnT[(c0 + 7) * VNT_LD + j] = (bf16_t)(p3 >> 16);
            }
        } else {
#pragma unroll 8
            for (int c = 0; c < 32; ++c) vnT[(32 * cq + c) * VNT_LD + j] = (bf16_t)0;
        }
    }
    const int il = lane & 15, kg = lane >> 4, i = 16 * w + il;
    const int nks = (sb >= 0) ? 1 : (w < 4 ? 2 : 4);
    bf16x8 Bf[4];
#pragma unroll
    for (int ks = 0; ks < 4; ++ks) {
        if (ks < nks) { const float* wp = w_s + (size_t)g * 16384 + i * 128 + 32 * ks + 8 * kg; const f32x4 a0 = *(const f32x4*)wp, a1 = *(const f32x4*)(wp + 4);
            u32x4 pk; pk.x = cvt_pk_bf16(a0[0], a0[1]); pk.y = cvt_pk_bf16(a0[2], a0[3]); pk.z = cvt_pk_bf16(a1[0], a1[1]); pk.w = cvt_pk_bf16(a1[2], a1[3]);
            Bf[ks] = __builtin_bit_cast(bf16x8, pk); }
        else Bf[ks] = (bf16x8){0, 0, 0, 0, 0, 0, 0, 0};
    }
    __syncthreads();
    if (sb >= 0 && w >= 2) return;
    f32x4 acc[8];
#pragma unroll
    for (int cb = 0; cb < 8; ++cb) {
        acc[cb] = (f32x4){0.f, 0.f, 0.f, 0.f};
#pragma unroll
        for (int ks = 0; ks < 4; ++ks)
            if (ks < nks) { const bf16x8 Af = *(const LAS bf16x8*)(vnT + (16 * cb + il) * VNT_LD + 32 * ks + 8 * kg);
                acc[cb] = __builtin_amdgcn_mfma_f32_16x16x32_bf16(Af, Bf[ks], acc[cb], 0, 0, 0); }
    }
    if (i < nrows) {
        const float bs = b_s[g * 128 + i]; const size_t row = (size_t)(row0 + i);
        u32x2 uw[8];
#pragma unroll
        for (int cb = 0; cb < 8; ++cb) uw[cb] = __builtin_nontemporal_load((const u32x2*)(U + row * 1024 + 128 * g + 16 * cb + 4 * kg));
#pragma unroll
        for (int cb = 0; cb < 8; ++cb) {
            const int c = 128 * g + 16 * cb + 4 * kg;
            const f32x4 uu = (f32x4){bf_lo(uw[cb].x), bf_hi(uw[cb].x), bf_lo(uw[cb].y), bf_hi(uw[cb].y)};
            const f32x4 r = uu * (acc[cb] + bs);
            u32x2 o; o.x = cvt_pk_bf16(r[0], r[1]); o.y = cvt_pk_bf16(r[2], r[3]);
            *(u32x2*)(AO + row * 2048 + c) = o;
        }
    }
}

__device__ __forceinline__ void attn_unit(LAS unsigned char* lds, const Args& a, int b, int cn, int kvh, int sb) {
    const int tid = threadIdx.x, w = __builtin_amdgcn_readfirstlane(tid >> 6), lane = tid & 63, il = lane & 15, kg = lane >> 4;
    unsigned char* ws = a.ws;
    const bf16_t* Q = (const bf16_t*)(ws + WS_Q); const bf16_t* Kb = (const bf16_t*)(ws + WS_K); const bf16_t* Vb = (const bf16_t*)(ws + WS_V); bf16_t* AO = (bf16_t*)(ws + WS_AO);
    LAS bf16_t* Ks = (LAS bf16_t*)lds; LAS bf16_t* VT = (LAS bf16_t*)(lds + VT_OFF);
    const bool samp = sb >= 0;
    __syncthreads();
#pragma unroll
    for (int p = 0; p < 3; ++p) {
        const int idx = p * NTHR + tid, key = idx >> 3, part = idx & 7;
        u32x4 k8 = (u32x4){0u, 0u, 0u, 0u}, v8 = (u32x4){0u, 0u, 0u, 0u};
        if (!samp) {
            const int pos = 64 * (cn - 2) + key;
            if (pos >= 0) { const size_t off = (size_t)(b * SEQ + pos) * 256 + kvh * 64 + part * 8; k8 = *(const u32x4*)(Kb + off); v8 = *(const u32x4*)(Vb + off); }
        } else if (key < 128) {
            const size_t off = ((size_t)(sb * 128 + key) * 4 + kvh) * 64 + part * 8;
            const f32x4 k0 = *(const f32x4*)(a.in[2] + off), k1 = *(const f32x4*)(a.in[2] + off + 4), v0 = *(const f32x4*)(a.in[3] + off), v1 = *(const f32x4*)(a.in[3] + off + 4);
            k8.x = cvt_pk_bf16(k0[0], k0[1]); k8.y = cvt_pk_bf16(k0[2], k0[3]); k8.z = cvt_pk_bf16(k1[0], k1[1]); k8.w = cvt_pk_bf16(k1[2], k1[3]);
            v8.x = cvt_pk_bf16(v0[0], v0[1]); v8.y = cvt_pk_bf16(v0[2], v0[3]); v8.z = cvt_pk_bf16(v1[0], v1[1]); v8.w = cvt_pk_bf16(v1[2], v1[3]);
        } else if (key < 160) {
            const size_t off = (size_t)(MP + sb * 32 + key - 128) * 256 + kvh * 64 + part * 8; k8 = *(const u32x4*)(Kb + off); v8 = *(const u32x4*)(Vb + off);
        }
        *(LAS u32x4*)(Ks + key * KS_LD + part * 8) = k8;
        LAS bf16_t* vt = VT + (part * 8) * VT_LD + key;
        vt[0 * VT_LD] = (bf16_t)(v8.x & 0xffff); vt[1 * VT_LD] = (bf16_t)(v8.x >> 16); vt[2 * VT_LD] = (bf16_t)(v8.y & 0xffff); vt[3 * VT_LD] = (bf16_t)(v8.y >> 16);
        vt[4 * VT_LD] = (bf16_t)(v8.z & 0xffff); vt[5 * VT_LD] = (bf16_t)(v8.z >> 16); vt[6 * VT_LD] = (bf16_t)(v8.w & 0xffff); vt[7 * VT_LD] = (bf16_t)(v8.w >> 16);
    }
    const int hq = 4 * kvh + (w >> 1);
    const int qrow0 = samp ? MP + sb * 32 + (w & 1) * 16 : b * SEQ + 64 * cn + (w & 1) * 32;
    const int kb_lo = samp ? 0 : (cn < 2 ? 4 * (2 - cn) : 0), kb_hi = samp ? 10 : 12;
    bf16x8 Qf[2][2];
#pragma unroll
    for (int qb = 0; qb < 2; ++qb) { const int row = qrow0 + ((samp && qb) ? 0 : 16 * qb) + il;
#pragma unroll
        for (int ks = 0; ks < 2; ++ks) Qf[qb][ks] = *(const bf16x8*)(Q + (size_t)row * 1024 + hq * 64 + 32 * ks + 8 * kg); }
    __syncthreads();
    f32x4 S[2][12];
#pragma unroll
    for (int kb = 0; kb < 12; ++kb) {
#pragma unroll
        for (int qb = 0; qb < 2; ++qb) S[qb][kb] = (f32x4){0.f, 0.f, 0.f, 0.f};
        if (kb >= kb_lo && kb < kb_hi) {
#pragma unroll
            for (int ks = 0; ks < 2; ++ks) { const bf16x8 Kf = *(const LAS bf16x8*)(Ks + (16 * kb + il) * KS_LD + 32 * ks + 8 * kg);
#pragma unroll
                for (int qb = 0; qb < 2; ++qb) S[qb][kb] = __builtin_amdgcn_mfma_f32_16x16x32_bf16(Kf, Qf[qb][ks], S[qb][kb], 0, 0, 0); }
        }
    }
    const float sink = a.in[20][hq];
    float linv[2];
#pragma unroll
    for (int qb = 0; qb < 2; ++qb) {
        float mx = sink;
#pragma unroll
        for (int kb = 0; kb < 12; ++kb) if (kb >= kb_lo && kb < kb_hi) {
#pragma unroll
            for (int e = 0; e < 4; ++e) { S[qb][kb][e] *= 0.125f; mx = fmaxf(mx, S[qb][kb][e]); } }
        mx = fmaxf(mx, __shfl_xor(mx, 16)); mx = fmaxf(mx, __shfl_xor(mx, 32));
        float l = 0.f;
#pragma unroll
        for (int kb = 0; kb < 12; ++kb) {
            if (kb >= kb_lo && kb < kb_hi) {
#pragma unroll
                for (int e = 0; e < 4; ++e) { const float p = __expf(S[qb][kb][e] - mx); S[qb][kb][e] = p; l += p; }
            } else S[qb][kb] = (f32x4){0.f, 0.f, 0.f, 0.f};
        }
        l += __shfl_xor(l, 16); l += __shfl_xor(l, 32);
        l += __expf(sink - mx);
        linv[qb] = 1.0f / l;
    }
    f32x4 O[2][4];
#pragma unroll
    for (int qb = 0; qb < 2; ++qb)
#pragma unroll
        for (int db = 0; db < 4; ++db) O[qb][db] = (f32x4){0.f, 0.f, 0.f, 0.f};
#pragma unroll
    for (int t = 0; t < 6; ++t) {
        if (2 * t + 1 >= kb_lo && 2 * t < kb_hi) {
            bf16x8 Pf[2];
#pragma unroll
            for (int qb = 0; qb < 2; ++qb) { u32x4 pk; pk.x = cvt_pk_bf16(S[qb][2 * t][0], S[qb][2 * t][1]); pk.y = cvt_pk_bf16(S[qb][2 * t][2], S[qb][2 * t][3]);
                pk.z = cvt_pk_bf16(S[qb][2 * t + 1][0], S[qb][2 * t + 1][1]); pk.w = cvt_pk_bf16(S[qb][2 * t + 1][2], S[qb][2 * t + 1][3]); Pf[qb] = __builtin_bit_cast(bf16x8, pk); }
#pragma unroll
            for (int db = 0; db < 4; ++db) {
                const LAS bf16_t* vp = VT + (16 * db + il) * VT_LD + 32 * t + 4 * kg;
                const u32x2 lo = *(const LAS u32x2*)vp, hi = *(const LAS u32x2*)(vp + 16);
                const bf16x8 Vf = __builtin_bit_cast(bf16x8, (u32x4){lo.x, lo.y, hi.x, hi.y});
#pragma unroll
                for (int qb = 0; qb < 2; ++qb) O[qb][db] = __builtin_amdgcn_mfma_f32_16x16x32_bf16(Vf, Pf[qb], O[qb][db], 0, 0, 0);
            }
        }
    }
#pragma unroll
    for (int qb = 0; qb < 2; ++qb) {
        if (samp && qb) continue;
        const size_t row = (size_t)(qrow0 + 16 * qb + il);
#pragma unroll
        for (int db = 0; db < 4; ++db) { const f32x4 r = O[qb][db] * linv[qb]; u32x2 o; o.x = cvt_pk_bf16(r[0], r[1]); o.y = cvt_pk_bf16(r[2], r[3]);
            *(u32x2*)(AO + row * 2048 + 1024 + hq * 64 + 16 * db + 4 * kg) = o; }
    }
}


struct AttnPre { u32x4 k8[3], v8[3]; bf16x8 qf[2][2]; };
__device__ __forceinline__ void attn_pre_load(const Args& a, int it, AttnPre& P) {
    const int tid = threadIdx.x, w = __builtin_amdgcn_readfirstlane(tid >> 6), lane = tid & 63, il = lane & 15, kg = lane >> 4;
    const bf16_t* Q = (const bf16_t*)(a.ws + WS_Q); const bf16_t* Kb = (const bf16_t*)(a.ws + WS_K); const bf16_t* Vb = (const bf16_t*)(a.ws + WS_V);
    const int b = it >> 9, cn = (it >> 2) & 127, kvh = it & 3;
#pragma unroll
    for (int p = 0; p < 3; ++p) {
        const int idx = p * NTHR + tid, key = idx >> 3, part = idx & 7, pos = 64 * (cn - 2) + key;
        P.k8[p] = (u32x4){0u, 0u, 0u, 0u}; P.v8[p] = (u32x4){0u, 0u, 0u, 0u};
        if (pos >= 0) { const size_t off = (size_t)(b * SEQ + pos) * 256 + kvh * 64 + part * 8; P.k8[p] = *(const u32x4*)(Kb + off); P.v8[p] = *(const u32x4*)(Vb + off); }
    }
    const int hq = 4 * kvh + (w >> 1), qrow0 = b * SEQ + 64 * cn + (w & 1) * 32;
#pragma unroll
    for (int qb = 0; qb < 2; ++qb)
#pragma unroll
        for (int ks = 0; ks < 2; ++ks) P.qf[qb][ks] = *(const bf16x8*)(Q + (size_t)(qrow0 + 16 * qb + il) * 1024 + hq * 64 + 32 * ks + 8 * kg);
}
__device__ __forceinline__ void attn_prompt_loop(LAS unsigned char* lds, const Args& a, int bx, int G) {
    const int tid = threadIdx.x, w = __builtin_amdgcn_readfirstlane(tid >> 6), lane = tid & 63, il = lane & 15, kg = lane >> 4;
    bf16_t* AO = (bf16_t*)(a.ws + WS_AO);
    LAS bf16_t* Ks = (LAS bf16_t*)lds; LAS bf16_t* VT = (LAS bf16_t*)(lds + VT_OFF);
    AttnPre P;
    if (bx < 2048) attn_pre_load(a, bx, P);
    for (int it = bx; it < 2048; it += G) {
        const int b = it >> 9, cn = (it >> 2) & 127, kvh = it & 3;
        __syncthreads();
#pragma unroll
        for (int p = 0; p < 3; ++p) {
            const int idx = p * NTHR + tid, key = idx >> 3, part = idx & 7;
            const u32x4 k8 = P.k8[p], v8 = P.v8[p];
            *(LAS u32x4*)(Ks + key * KS_LD + part * 8) = k8;
            LAS bf16_t* vt = VT + (part * 8) * VT_LD + key;
            vt[0 * VT_LD] = (bf16_t)(v8.x & 0xffff); vt[1 * VT_LD] = (bf16_t)(v8.x >> 16); vt[2 * VT_LD] = (bf16_t)(v8.y & 0xffff); vt[3 * VT_LD] = (bf16_t)(v8.y >> 16);
            vt[4 * VT_LD] = (bf16_t)(v8.z & 0xffff); vt[5 * VT_LD] = (bf16_t)(v8.z >> 16); vt[6 * VT_LD] = (bf16_t)(v8.w & 0xffff); vt[7 * VT_LD] = (bf16_t)(v8.w >> 16);
        }
        bf16x8 Qf[2][2];
#pragma unroll
        for (int qb = 0; qb < 2; ++qb)
#pragma unroll
            for (int ks = 0; ks < 2; ++ks) Qf[qb][ks] = P.qf[qb][ks];
        if (it + G < 2048) attn_pre_load(a, it + G, P);
        __syncthreads();
        const int hq = 4 * kvh + (w >> 1), qrow0 = b * SEQ + 64 * cn + (w & 1) * 32;
        const int kb_lo = cn < 2 ? 4 * (2 - cn) : 0;
        f32x4 S[2][12];
#pragma unroll
        for (int kb = 0; kb < 12; ++kb) {
#pragma unroll
            for (int qb = 0; qb < 2; ++qb) S[qb][kb] = (f32x4){0.f, 0.f, 0.f, 0.f};
            if (kb >= kb_lo) {
#pragma unroll
                for (int ks = 0; ks < 2; ++ks) { const bf16x8 Kf = *(const LAS bf16x8*)(Ks + (16 * kb + il) * KS_LD + 32 * ks + 8 * kg);
#pragma unroll
                    for (int qb = 0; qb < 2; ++qb) S[qb][kb] = __builtin_amdgcn_mfma_f32_16x16x32_bf16(Kf, Qf[qb][ks], S[qb][kb], 0, 0, 0); }
            }
        }
        const float sink = a.in[20][hq];
        float linv[2];
#pragma unroll
        for (int qb = 0; qb < 2; ++qb) {
            float mx = sink;
#pragma unroll
            for (int kb = 0; kb < 12; ++kb) if (kb >= kb_lo) {
#pragma unroll
                for (int e = 0; e < 4; ++e) { S[qb][kb][e] *= 0.125f; mx = fmaxf(mx, S[qb][kb][e]); } }
            mx = fmaxf(mx, __shfl_xor(mx, 16)); mx = fmaxf(mx, __shfl_xor(mx, 32));
            float l = 0.f;
#pragma unroll
            for (int kb = 0; kb < 12; ++kb) {
                if (kb >= kb_lo) {
#pragma unroll
                    for (int e = 0; e < 4; ++e) { const float pv = __expf(S[qb][kb][e] - mx); S[qb][kb][e] = pv; l += pv; }
                } else S[qb][kb] = (f32x4){0.f, 0.f, 0.f, 0.f};
            }
            l += __shfl_xor(l, 16); l += __shfl_xor(l, 32);
            l += __expf(sink - mx);
            linv[qb] = 1.0f / l;
        }
        f32x4 O[2][4];
#pragma unroll
        for (int qb = 0; qb < 2; ++qb)
#pragma unroll
            for (int db = 0; db < 4; ++db) O[qb][db] = (f32x4){0.f, 0.f, 0.f, 0.f};
#pragma unroll
        for (int t = 0; t < 6; ++t) {
            if (2 * t + 1 >= kb_lo) {
                bf16x8 Pf[2];
#pragma unroll
                for (int qb = 0; qb < 2; ++qb) { u32x4 pk; pk.x = cvt_pk_bf16(S[qb][2 * t][0], S[qb][2 * t][1]); pk.y = cvt_pk_bf16(S[qb][2 * t][2], S[qb][2 * t][3]);
                    pk.z = cvt_pk_bf16(S[qb][2 * t + 1][0], S[qb][2 * t + 1][1]); pk.w = cvt_pk_bf16(S[qb][2 * t + 1][2], S[qb][2 * t + 1][3]); Pf[qb] = __builtin_bit_cast(bf16x8, pk); }
#pragma unroll
                for (int db = 0; db < 4; ++db) {
                    const LAS bf16_t* vp = VT + (16 * db + il) * VT_LD + 32 * t + 4 * kg;
                    const u32x2 lo = *(const LAS u32x2*)vp, hi = *(const LAS u32x2*)(vp + 16);
                    const bf16x8 Vf = __builtin_bit_cast(bf16x8, (u32x4){lo.x, lo.y, hi.x, hi.y});
#pragma unroll
                    for (int qb = 0; qb < 2; ++qb) O[qb][db] = __builtin_amdgcn_mfma_f32_16x16x32_bf16(Vf, Pf[qb], O[qb][db], 0, 0, 0);
                }
            }
        }
#pragma unroll
        for (int qb = 0; qb < 2; ++qb) {
            const size_t row = (size_t)(qrow0 + 16 * qb + il);
#pragma unroll
            for (int db = 0; db < 4; ++db) { const f32x4 r = O[qb][db] * linv[qb]; u32x2 o; o.x = cvt_pk_bf16(r[0], r[1]); o.y = cvt_pk_bf16(r[2], r[3]);
                *(u32x2*)(AO + row * 2048 + 1024 + hq * 64 + 16 * db + 4 * kg) = o; }
        }
    }
}

struct SpPre { f32x4 st[2]; u32x4 gv[4]; u32x2 uw[8]; };
__device__ __forceinline__ void sp_pre_load(const Args& a, int it, SpPre& P) {
    const int tid = threadIdx.x, w = __builtin_amdgcn_readfirstlane(tid >> 6), lane = tid & 63, il = lane & 15, kg = lane >> 4;
    const bf16_t* GV = (const bf16_t*)(a.ws + WS_GV); const bf16_t* U = (const bf16_t*)(a.ws + WS_U); const f32x2* stats = (const f32x2*)(a.ws + WS_STATS);
    const int g = it & 7, row0 = (it >> 3) * 128, j = tid >> 2, cq = tid & 3;
    const f32x4* st = (const f32x4*)(stats + (size_t)(row0 + j) * 16) + 2 * cq;
    P.st[0] = st[0]; P.st[1] = st[1];
    const u32x4* src = (const u32x4*)(GV + (size_t)(row0 + j) * 1024 + 128 * g + 32 * cq);
#pragma unroll
    for (int q = 0; q < 4; ++q) P.gv[q] = __builtin_nontemporal_load(src + q);
    const size_t urow = (size_t)(row0 + 16 * w + il);
#pragma unroll
    for (int cb = 0; cb < 8; ++cb) P.uw[cb] = __builtin_nontemporal_load((const u32x2*)(U + urow * 1024 + 128 * g + 16 * cb + 4 * kg));
}
__device__ __forceinline__ void spatial_prompt_loop(LAS unsigned char* lds, const Args& a, int bx, int G) {
    const int tid = threadIdx.x, w = __builtin_amdgcn_readfirstlane(tid >> 6), lane = tid & 63, il = lane & 15, kg = lane >> 4;
    bf16_t* AO = (bf16_t*)(a.ws + WS_AO);
    const float* lng = a.in[16]; const float* lnb = a.in[17]; const float* w_s = a.in[18]; const float* b_s = a.in[19];
    LAS bf16_t* vnT = (LAS bf16_t*)lds;
    SpPre P;
    if (bx < 2048) sp_pre_load(a, bx, P);
    for (int it = bx; it < 2048; it += G) {
        const int g = it & 7, row0 = (it >> 3) * 128;
        __syncthreads();
        {
            const int j = tid >> 2, cq = tid & 3;
            float s1 = (P.st[0][0] + P.st[0][2]) + (P.st[1][0] + P.st[1][2]), s2 = (P.st[0][1] + P.st[0][3]) + (P.st[1][1] + P.st[1][3]);
            s1 += __shfl_xor(s1, 1); s1 += __shfl_xor(s1, 2); s2 += __shfl_xor(s2, 1); s2 += __shfl_xor(s2, 2);
            const float mean = s1 * (1.0f / 1024.0f), var = s2 * (1.0f / 1024.0f) - mean * mean, rstd = rsqrtf(var + EPS);
#pragma unroll
            for (int q = 0; q < 4; ++q) {
                const u32x4 pk = P.gv[q]; const int c0 = 32 * cq + 8 * q;
                const f32x4 ga = *(const f32x4*)(lng + 128 * g + c0), gb = *(const f32x4*)(lng + 128 * g + c0 + 4), ba = *(const f32x4*)(lnb + 128 * g + c0), bb = *(const f32x4*)(lnb + 128 * g + c0 + 4);
                f32x4 x0 = (f32x4){bf_lo(pk.x), bf_hi(pk.x), bf_lo(pk.y), bf_hi(pk.y)}, x1 = (f32x4){bf_lo(pk.z), bf_hi(pk.z), bf_lo(pk.w), bf_hi(pk.w)};
                x0 = (x0 - mean) * rstd * ga + ba; x1 = (x1 - mean) * rstd * gb + bb;
                const unsigned p0 = cvt_pk_bf16(x0[0], x0[1]), p1 = cvt_pk_bf16(x0[2], x0[3]), p2 = cvt_pk_bf16(x1[0], x1[1]), p3 = cvt_pk_bf16(x1[2], x1[3]);
                vnT[(c0 + 0) * VNT_LD + j] = (bf16_t)(p0 & 0xffff); vnT[(c0 + 1) * VNT_LD + j] = (bf16_t)(p0 >> 16);
                vnT[(c0 + 2) * VNT_LD + j] = (bf16_t)(p1 & 0xffff); vnT[(c0 + 3) * VNT_LD + j] = (bf16_t)(p1 >> 16);
                vnT[(c0 + 4) * VNT_LD + j] = (bf16_t)(p2 & 0xffff); vnT[(c0 + 5) * VNT_LD + j] = (bf16_t)(p2 >> 16);
                vnT[(c0 + 6) * VNT_LD + j] = (bf16_t)(p3 & 0xffff); vnT[(c0 + 7) * VNT_LD + j] = (bf16_t)(p3 >> 16);
            }
        }
        u32x2 uw[8];
#pragma unroll
        for (int cb = 0; cb < 8; ++cb) uw[cb] = P.uw[cb];
        const int i = 16 * w + il, nks = w < 4 ? 2 : 4;
        bf16x8 Bf[4];
#pragma unroll
        for (int ks = 0; ks < 4; ++ks) {
            if (ks < nks) { const float* wp = w_s + (size_t)g * 16384 + i * 128 + 32 * ks + 8 * kg; const f32x4 a0 = *(const f32x4*)wp, a1 = *(const f32x4*)(wp + 4);
                u32x4 pk; pk.x = cvt_pk_bf16(a0[0], a0[1]); pk.y = cvt_pk_bf16(a0[2], a0[3]); pk.z = cvt_pk_bf16(a1[0], a1[1]); pk.w = cvt_pk_bf16(a1[2], a1[3]);
                Bf[ks] = __builtin_bit_cast(bf16x8, pk); }
            else Bf[ks] = (bf16x8){0, 0, 0, 0, 0, 0, 0, 0};
        }
        const float bs = b_s[g * 128 + i];
        if (it + G < 2048) sp_pre_load(a, it + G, P);
        __syncthreads();
        f32x4 acc[8];
#pragma unroll
        for (int cb = 0; cb < 8; ++cb) {
            acc[cb] = (f32x4){0.f, 0.f, 0.f, 0.f};
#pragma unroll
            for (int ks = 0; ks < 4; ++ks)
                if (ks < nks) { const bf16x8 Af = *(const LAS bf16x8*)(vnT + (16 * cb + il) * VNT_LD + 32 * ks + 8 * kg);
                    acc[cb] = __builtin_amdgcn_mfma_f32_16x16x32_bf16(Af, Bf[ks], acc[cb], 0, 0, 0); }
        }
        const size_t row = (size_t)(row0 + i);
#pragma unroll
        for (int cb = 0; cb < 8; ++cb) {
            const f32x4 uu = (f32x4){bf_lo(uw[cb].x), bf_hi(uw[cb].x), bf_lo(uw[cb].y), bf_hi(uw[cb].y)};
            const f32x4 r = uu * (acc[cb] + bs);
            u32x2 o; o.x = cvt_pk_bf16(r[0], r[1]); o.y = cvt_pk_bf16(r[2], r[3]);
            *(u32x2*)(AO + row * 2048 + 128 * g + 16 * cb + 4 * kg) = o;
        }
    }
}

#define XB_TMO      128
#define XB_XCNT(j)  (256  + 64 * (j))
#define XB_XSUB(j)  (1280 + 64 * (j))
#define XB_XGEN(j)  (2304 + 64 * (j))
#define XB_TOP      3328
#define XB_TOPGEN   3392
#define XCD_BAR_WORDS 3456
#define XB_SPIN_CAP (1u << 18)
__device__ __forceinline__ unsigned xb_ld(unsigned* p)              { return __hip_atomic_load(p, __ATOMIC_RELAXED, __HIP_MEMORY_SCOPE_AGENT); }
__device__ __forceinline__ unsigned xb_add(unsigned* p, unsigned v) { return __hip_atomic_fetch_add(p, v, __ATOMIC_RELAXED, __HIP_MEMORY_SCOPE_AGENT); }
__device__ __forceinline__ unsigned xb_xcc_id() { return (unsigned)__builtin_amdgcn_s_getreg((3 << 11) | 20) & 0xFu; }
#define XB_SPIN(cond, bar) do { unsigned _sp = 0; while (cond) { __builtin_amdgcn_s_sleep(1); \
    if ((++_sp & 255u) == 0u) { if (xb_ld(&(bar)[XB_TMO])) break; if (_sp > XB_SPIN_CAP) { atomicAdd(&(bar)[XB_TMO], 1u); break; } } } } while (0)
struct XcdBarrier { unsigned* bar; unsigned x; volatile LAS unsigned* st; };
__device__ __forceinline__ XcdBarrier xcd_barrier_post(unsigned* bar, volatile LAS unsigned* st) {
    XcdBarrier b; b.bar = bar; b.x = xb_xcc_id(); b.st = st;
    if (threadIdx.x == 0) (void)xb_add(&bar[XB_XCNT(b.x)], 1u);
    return b;
}
__device__ __forceinline__ void xcd_barrier_complete(unsigned* bar, unsigned x, unsigned& nloc, unsigned& nx) {
    const unsigned G = gridDim.x * gridDim.y * gridDim.z;
    unsigned sum, cnt, mine, sp = 0u;
    for (;;) {
        sum = 0u; cnt = 0u; mine = 0u;
#pragma unroll
        for (unsigned j = 0; j < 16; ++j) { const unsigned c = xb_ld(&bar[XB_XCNT(j)]); sum += c; cnt += (c > 0u) ? 1u : 0u; mine = (j == x) ? c : mine; }
        if (sum == G) break;
        __builtin_amdgcn_s_sleep(1);
        if ((++sp & 255u) == 0u) { if (xb_ld(&bar[XB_TMO])) break; if (sp > XB_SPIN_CAP) { atomicAdd(&bar[XB_TMO], 1u); break; } }
    }
    nloc = mine > 0u ? mine : 1u; nx = cnt > 0u ? cnt : 1u;
}
__device__ __forceinline__ void xcd_barrier(const XcdBarrier& b) {
    asm volatile("s_waitcnt vmcnt(0)" ::: "memory");
    __syncthreads();
    if (threadIdx.x == 0) {
        unsigned* bar = b.bar;
        __builtin_amdgcn_s_waitcnt(0);
        unsigned nloc = b.st[0], nx = b.st[1];
        if (nloc == 0u) { xcd_barrier_complete(bar, b.x, nloc, nx); b.st[0] = nloc; b.st[1] = nx; }
        const unsigned old = xb_add(&bar[XB_XSUB(b.x)], 1u);
        const unsigned gen = old / nloc;
        if (old + 1u == (gen + 1u) * nloc) {
            __builtin_amdgcn_fence(__ATOMIC_RELEASE, "agent");
            asm volatile("s_waitcnt vmcnt(0)" ::: "memory");
            const unsigned og = xb_add(&bar[XB_TOP], 1u);
            const unsigned tg = og / nx;
            if (og + 1u == (tg + 1u) * nx) xb_add(&bar[XB_TOPGEN], 1u);
            else XB_SPIN(xb_ld(&bar[XB_TOPGEN]) == tg, bar);
            __builtin_amdgcn_fence(__ATOMIC_ACQUIRE, "agent");
            xb_add(&bar[XB_XGEN(b.x)], 1u);
            asm volatile("s_waitcnt vmcnt(0)" ::: "memory");
        } else {
            XB_SPIN(xb_ld(&bar[XB_XGEN(b.x)]) == gen, bar);
            __builtin_amdgcn_fence(__ATOMIC_ACQUIRE, "agent");
            asm volatile("s_waitcnt vmcnt(0)" ::: "memory");
        }
    }
    __syncthreads();
}

__device__ __forceinline__ f32x4 skinny_dot(const bf16_t* ap, const bf16_t* bp, int nks, f32x4 acc, size_t planeA = 64, size_t planeB = 64) {
#pragma unroll 8
    for (int ks = 0; ks < nks; ++ks) { const bf16x8 av = *(const bf16x8*)(ap + (size_t)(ks >> 1) * planeA + (ks & 1) * 32), bv = *(const bf16x8*)(bp + (size_t)(ks >> 1) * planeB + (ks & 1) * 32);
        acc = __builtin_amdgcn_mfma_f32_16x16x32_bf16(bv, av, acc, 0, 0, 0); }
    return acc;
}
template <bool BASE_BF16, bool OUT_BF16>
__device__ __forceinline__ void skinny_resid(const bf16_t* A, int lda, size_t planeA, const bf16_t* Bt, int ldb, size_t planeB, int K, const void* baseS, void* outS, const float* gate, float coef, int bx, int G) {
    const int tid = threadIdx.x, w = __builtin_amdgcn_readfirstlane(tid >> 6), lane = tid & 63, il = lane & 15, kg = lane >> 4;
    for (int it = bx; it < 256; it += G) {
        const int cb = it >> 1, r = (it & 1) * 128 + 16 * w + il, col = 16 * cb + 4 * kg;
        const f32x4 acc = skinny_dot(A + (size_t)(MP + r) * lda + 8 * kg, Bt + (size_t)(16 * cb + il) * ldb + 8 * kg, K / 32, (f32x4){0.f, 0.f, 0.f, 0.f}, planeA, planeB);
        const f32x4 gg = *(const f32x4*)(gate + (size_t)(4 + (r >> 5)) * MODW + col) * coef;
        f32x4 b;
        if (BASE_BF16) { const u32x2 bw = *(const u32x2*)((const bf16_t*)baseS + (size_t)r * DM + col); b = (f32x4){bf_lo(bw.x), bf_hi(bw.x), bf_lo(bw.y), bf_hi(bw.y)}; }
        else b = *(const f32x4*)((const float*)baseS + (size_t)r * DM + col);
        const f32x4 o = b + gg * acc;
        if (OUT_BF16) { u32x2 pk; pk.x = cvt_pk_bf16(o[0], o[1]); pk.y = cvt_pk_bf16(o[2], o[3]); *(u32x2*)((bf16_t*)outS + (size_t)r * DM + col) = pk; }
        else *(f32x4*)((float*)outS + (size_t)r * DM + col) = o;
    }
}
__device__ __forceinline__ void skinny_merge(const bf16_t* AO, const bf16_t* WPAB, const bf16_t* GA, const bf16_t* GB, bf16_t* Y, int bx, int G) {
    const int tid = threadIdx.x, w = __builtin_amdgcn_readfirstlane(tid >> 6), lane = tid & 63, il = lane & 15, kg = lane >> 4;
    for (int it = bx; it < 256; it += G) {
        const int cb = it >> 1, r = (it & 1) * 128 + 16 * w + il, col = 16 * cb + 4 * kg;
        const bf16_t* ap = AO + (size_t)(MP + r) * 2048 + 8 * kg; const bf16_t* bp = WPAB + (size_t)(16 * cb + il) * 2048 + 8 * kg;
        const f32x4 a1 = skinny_dot(ap, bp, 32, (f32x4){0.f, 0.f, 0.f, 0.f}), a2 = skinny_dot(ap + 1024, bp + 1024, 32, (f32x4){0.f, 0.f, 0.f, 0.f});
        const size_t o = (size_t)(MP + r) * DM + col;
        const u32x2 ga = *(const u32x2*)(GA + o), gb = *(const u32x2*)(GB + o);
        const f32x4 sa = (f32x4){bf_lo(ga.x), bf_hi(ga.x), bf_lo(ga.y), bf_hi(ga.y)}, sb = (f32x4){bf_lo(gb.x), bf_hi(gb.x), bf_lo(gb.y), bf_hi(gb.y)};
        const f32x4 y = sa * a1 + sb * a2;
        u32x2 pk; pk.x = cvt_pk_bf16(y[0], y[1]); pk.y = cvt_pk_bf16(y[2], y[3]);
        *(u32x2*)(Y + o) = pk;
    }
}

#ifndef STAG_TICKS
#define STAG_TICKS 800
#endif
__device__ __forceinline__ void stagger(int grp) {
    const unsigned long long t0 = __builtin_amdgcn_s_memrealtime(), want = (unsigned long long)grp * STAG_TICKS;
    while (__builtin_amdgcn_s_memrealtime() - t0 < want) __builtin_amdgcn_s_sleep(8);
}

__global__ void __launch_bounds__(NTHR, 2) fwd_kernel(Args a) {
    extern __shared__ __attribute__((aligned(16))) unsigned char lds_raw[];
    LAS unsigned char* lds = (LAS unsigned char*)lds_raw;
    const int tid = threadIdx.x, lane = tid & 63, wave = __builtin_amdgcn_readfirstlane(tid >> 6);
    const int G = gridDim.x, bx = blockIdx.x;
    const int gw = bx * NWAVES + wave, NGW = G * NWAVES;
    unsigned char* ws = a.ws; float* out = a.out;
    float* MOD = (float*)(ws + WS_MOD); f32x2* ROPE = (f32x2*)(ws + WS_ROPE); f32x2* STATS = (f32x2*)(ws + WS_STATS);
    bf16_t* W13 = (bf16_t*)(ws + WS_W13); bf16_t* W2 = (bf16_t*)(ws + WS_W2); bf16_t* WIN = (bf16_t*)(ws + WS_WIN); bf16_t* WPAB = (bf16_t*)(ws + WS_WPAB); bf16_t* WO = (bf16_t*)(ws + WS_WO);
    bf16_t* X1b = (bf16_t*)(ws + WS_X1); bf16_t* X2b = (bf16_t*)(ws + WS_X1 + 129 * MiB); bf16_t* H = (bf16_t*)(ws + WS_H); bf16_t* Gb = (bf16_t*)(ws + WS_G);
    const int lo = a.ph_lo, hi = a.ph_hi;
    volatile LAS unsigned* MISC = (volatile LAS unsigned*)(lds + LDS_BYTES - 64);
    if (tid < 16) MISC[tid] = 0u;
    __syncthreads();
    XcdBarrier bar; bar.bar = (unsigned*)ws; bar.x = 0; bar.st = nullptr;
    if (hi - lo > 1) bar = xcd_barrier_post((unsigned*)ws, MISC);
#define IN(k) (lo <= (k) && (k) < hi)
#define SEAM(k) do { if (IN(k) && IN((k) + 1)) xcd_barrier(bar); } while (0)
    if (hi < 0) cg::this_grid().sync();

    if (IN(0)) REPS(0) {
        {
            const float invf[8] = {1.0f, 0.1939227432012558f, 0.03760603070259094f, 0.007292664609849453f, 0.0014142135623842478f, 0.00027424818836152554f, 5.318296098266728e-05f, 1.0313386155758053e-05f};
            for (int i = bx * NTHR + tid; i < SEQ * 8; i += G * NTHR) {
                const int pos = i >> 3, f = i & 7;
                float fv = invf[0];
#pragma unroll
                for (int q = 1; q < 8; ++q) fv = (f == q) ? invf[q] : fv;
                const float ang = (float)pos * fv;
                const double ad = (double)ang; const double n = __builtin_rint(ad * 0.15915494309189535); const float rr = (float)(ad - n * 6.283185307179586);
                ROPE[i] = (f32x2){cosf(rr), sinf(rr)};
            }
            for (int i = bx * NTHR + tid; i < 8 * 24576 / 4; i += G * NTHR) {
                const int b = i / 6144, o = (i - b * 6144) * 4;
                *(f32x4*)(out + O_KS + (size_t)b * 32768 + o) = *(const f32x4*)(a.in[2] + (size_t)b * 32768 + 8192 + o);
                *(f32x4*)(out + O_VS + (size_t)b * 32768 + o) = *(const f32x4*)(a.in[3] + (size_t)b * 32768 + 8192 + o);
            }
        }
        {
            LAS float* sl = (LAS float*)lds;
            LAS float* red = (LAS float*)(lds + 98304);
            __syncthreads();
            for (int idx = tid; idx < 12 * 2048; idx += NTHR) { const int r = idx >> 11, k = idx & 2047; const float c = r < 4 ? a.in[4][r * 2048 + k] : a.in[5][(r - 4) * 2048 + k]; sl[k * 12 + r] = c * sigmoidf_(c); }
            __syncthreads();
            for (int cb = bx; cb < MODW / 64; cb += G) {
                float acc[12];
#pragma unroll
                for (int r = 0; r < 12; ++r) acc[r] = 0.f;
                const float* wp = a.in[6] + (size_t)(wave * 256) * MODW + cb * 64 + lane;
#pragma unroll 8
                for (int k = 0; k < 256; ++k) {
                    const float wv = __builtin_nontemporal_load(wp + (size_t)k * MODW);
                    const LAS f32x4* sp = (const LAS f32x4*)(sl + (wave * 256 + k) * 12);
                    const f32x4 s0 = sp[0], s1 = sp[1], s2 = sp[2];
                    acc[0] += s0[0] * wv; acc[1] += s0[1] * wv; acc[2] += s0[2] * wv; acc[3] += s0[3] * wv;
                    acc[4] += s1[0] * wv; acc[5] += s1[1] * wv; acc[6] += s1[2] * wv; acc[7] += s1[3] * wv;
                    acc[8] += s2[0] * wv; acc[9] += s2[1] * wv; acc[10] += s2[2] * wv; acc[11] += s2[3] * wv;
                }
#pragma unroll
                for (int r = 0; r < 12; ++r) red[(wave * 12 + r) * 64 + lane] = acc[r];
                __syncthreads();
                for (int o = tid; o < 768; o += NTHR) { const int r = o >> 6, cl = o & 63; float s = a.in[7][cb * 64 + cl];
#pragma unroll
                    for (int q = 0; q < 8; ++q) s += red[(q * 12 + r) * 64 + cl];
                    MOD[(size_t)r * MODW + cb * 64 + cl] = s; }
                __syncthreads();
            }
        }
        __syncthreads();
        {
            LAS float* scr = (LAS float*)(lds + wave * 8448);
            const int nx2 = (MODW / 64 > G && MODW / 64 < 2 * G) ? MODW / 64 - G : 0;
            const int head = nx2 ? 2 * (G - nx2) * NWAVES : 0;
            if (nx2 && bx >= nx2) transpose_w13(a.in[9], a.in[10], W13, scr, (bx - nx2) * NWAVES + wave, (G - nx2) * NWAVES, lane, 0, head);
            transpose_w13(a.in[9], a.in[10], W13, scr, gw, NGW, lane, head, 2 * IT_FFN13); transpose_w2(a.in[11], W2, scr, gw, NGW, lane);
            for (int it = gw; it < IT_WIN; it += NGW) tr_mat(it, a.in[13], DM, DIN, WIN, DM, 0, 3, scr, lane);
        }
    }
    SEAM(0);
    if (IN(1)) REPS(1) norm_phase<false>(a.in[0], a.in[1], a.in[8], MOD, 0, H, gw, NGW, lane);
    SEAM(1);
    bf16_t* W13B = (bf16_t*)(out + O_Y); bf16_t* W2B = (bf16_t*)(ws + WS_W2B);
    if (IN(2)) REPS(2) { pg8::Gemm g{H, W13, MT, 2 * DFF, DM, DM, DM, 128, 128}; pg8::StaticOrder S; S.init(MT, 2 * DFF, G, bx); EpiSwiGLU E{Gb}; pg8::gemm_phase(lds, g, S, E);
        const int rem = S.nwg % G;
        if (rem == 0) transpose_w13(a.in[25], a.in[26], W13B, (LAS float*)(lds + wave * 8448), gw, NGW, lane, 0, W13_SPLIT);
        else if (bx >= rem) transpose_w13(a.in[25], a.in[26], W13B, (LAS float*)(lds + wave * 8448), (bx - rem) * NWAVES + wave, (G - rem) * NWAVES, lane, 0, W13_SPLIT); }
    SEAM(2);
    if (IN(3)) REPS(3) { skinny_resid<false, true>(Gb, 64, (size_t)MT * 64, W2, 64, (size_t)DM * 64, DFF, a.in[1], X1b + (size_t)MP * DM, MOD + 0 * 3 * DM + 2 * DM, 0.5f, bx, G);
        pg8::Gemm g{Gb, W2, MP, DM, DFF, 64, 64, (size_t)MT * 128, (size_t)DM * 128}; pg8::StaticOrder S; S.init(MP, DM, G, bx, 4); EpiResid<false, true> E{a.in[0], a.in[1], X1b, MOD + 0 * 3 * DM + 2 * DM, 0.5f}; pg8::gemm_phase(lds, g, S, E); }
    SEAM(3);
    if (IN(4)) REPS(4) {
        norm_phase<true>(X1b, nullptr, a.in[12], MOD, 1, H, gw, NGW, lane);
    }
    SEAM(4);
    if (IN(5)) REPS(5) { pg8::Gemm g{H, WIN, MT, DIN, DM, DM, DM, 128, 128}; pg8::StaticOrder S; S.init(MT, DIN, G, bx);
        EpiWin E{ws, STATS, a.in[14], a.in[15], ROPE, out};
        pg8::gemm_phase(lds, g, S, E);
        const int rem = S.nwg % G;
        if (rem == 0) { transpose_w13(a.in[25], a.in[26], W13B, (LAS float*)(lds + wave * 8448), gw, NGW, lane, W13_SPLIT, 2 * IT_FFN13); transpose_wpo(a.in[21], a.in[22], a.in[23], WPAB, WO, (LAS float*)(lds + wave * 8448), gw, NGW, lane); }
        else if (bx >= rem) { transpose_w13(a.in[25], a.in[26], W13B, (LAS float*)(lds + wave * 8448), (bx - rem) * NWAVES + wave, (G - rem) * NWAVES, lane, W13_SPLIT, 2 * IT_FFN13);
            transpose_wpo(a.in[21], a.in[22], a.in[23], WPAB, WO, (LAS float*)(lds + wave * 8448), (bx - rem) * NWAVES + wave, (G - rem) * NWAVES, lane); } }
    SEAM(5);
    if (IN(6)) REPS(6) {
        attn_prompt_loop(lds, a, bx, G);
        spatial_prompt_loop(lds, a, bx, G);
        for (int it = G - 1 - bx; it < 96; it += G) {
            if (it < 32) attn_unit(lds, a, 0, 0, it & 3, it >> 2);
            else spatial_unit(lds, a, MP + ((it - 32) >> 3) * 32, 32, it & 7, (it - 32) >> 3);
        }
        __syncthreads();
    }
    SEAM(6);
    if (IN(7)) REPS(7) {
        bf16_t* AO = (bf16_t*)(ws + WS_AO); bf16_t* Y = (bf16_t*)(ws + WS_Y);
        skinny_merge(AO, WPAB, (const bf16_t*)(ws + WS_GA), (const bf16_t*)(ws + WS_GB), Y, bx, G);
        pg8::Gemm g{AO, WPAB, MP, DM, 2048, 2048, 2048, 128, 128}; pg8::StaticOrder S; S.init(MP, DM, G, bx, 4); EpiMergeF E{(const bf16_t*)(ws + WS_GA), (const bf16_t*)(ws + WS_GB), Y}; pg8::gemm_phase(lds, g, S, E);
    }
    SEAM(7);
    if (IN(8)) REPS(8) { skinny_resid<true, true>((bf16_t*)(ws + WS_Y), DM, 64, WO, DM, 64, DM, X1b + (size_t)MP * DM, X2b + (size_t)MP * DM, MOD + 1 * 3 * DM + 2 * DM, 1.0f, bx, G);
        pg8::Gemm g{(bf16_t*)(ws + WS_Y), WO, MP, DM, DM, DM, DM, 128, 128}; pg8::StaticOrder S; S.init(MP, DM, G, bx, 4); EpiResid<true, true> E{X1b, nullptr, X2b, MOD + 1 * 3 * DM + 2 * DM, 1.0f}; pg8::gemm_phase(lds, g, S, E); }
    SEAM(8);
    if (IN(9)) REPS(9) norm_phase<true>(X2b, nullptr, a.in[24], MOD, 2, H, gw, NGW, lane);
    SEAM(9);
    if (IN(10)) REPS(10) { pg8::Gemm g{H, W13B, MT, 2 * DFF, DM, DM, DM, 128, 128}; pg8::StaticOrder S; S.init(MT, 2 * DFF, G, bx); EpiSwiGLU E{Gb}; pg8::gemm_phase(lds, g, S, E);
        const int rem = S.nwg % G;
        if (rem == 0) transpose_w2(a.in[27], W2B, (LAS float*)(lds + wave * 8448), gw, NGW, lane);
        else if (bx >= rem) transpose_w2(a.in[27], W2B, (LAS float*)(lds + wave * 8448), (bx - rem) * NWAVES + wave, (G - rem) * NWAVES, lane); }
    SEAM(10);
    if (IN(11)) { skinny_resid<true, false>(Gb, 64, (size_t)MT * 64, W2B, 64, (size_t)DM * 64, DFF, X2b + (size_t)MP * DM, out + O_Y + (size_t)MP * DM, MOD + 2 * 3 * DM + 2 * DM, 0.5f, bx, G);
        pg8::Gemm g{Gb, W2B, MP, DM, DFF, 64, 64, (size_t)MT * 128, (size_t)DM * 128}; pg8::StaticOrder S; S.init(MP, DM, G, bx, 4); EpiResid<true, false> E{X2b, nullptr, out + O_Y, MOD + 2 * 3 * DM + 2 * DM, 0.5f}; pg8::gemm_phase(lds, g, S, E); }
#undef IN
#undef SEAM
}

extern "C" void kernel_launch(void* const* d_in, const int* in_sizes, int n_in, void* d_out, int out_size, void* d_ws, size_t ws_size, hipStream_t stream) {
    static int grid = 0;
    if (grid == 0) {
        if (n_in != 28 || (size_t)out_size != O_END || ws_size < 1024 * MiB) { fprintf(stderr, "kernel_launch: unexpected shapes: n_in %d out %d ws %zu\n", n_in, out_size, ws_size); grid = -1; return; }
        int dev = 0, cus = 0, per_cu = 0;
        if (hipGetDevice(&dev) != hipSuccess || hipDeviceGetAttribute(&cus, hipDeviceAttributeMultiprocessorCount, dev) != hipSuccess) { grid = -1; return; }
        if (hipFuncSetAttribute((const void*)fwd_kernel, hipFuncAttributeMaxDynamicSharedMemorySize, LDS_BYTES) != hipSuccess) { fprintf(stderr, "kernel_launch: hipFuncSetAttribute failed\n"); grid = -1; return; }
        if (hipOccupancyMaxActiveBlocksPerMultiprocessor(&per_cu, (const void*)fwd_kernel, NTHR, LDS_BYTES) != hipSuccess || per_cu < 1) { fprintf(stderr, "kernel_launch: occupancy query says %d\n", per_cu); per_cu = 1; }
        (void)hipGetLastError();
        grid = cus * 1;
        fprintf(stderr, "kernel_launch: grid %d (cus %d, per_cu %d)\n", grid, cus, per_cu);
    }
    if (grid < 0) return;
    if (hipMemsetAsync(d_ws, 0, 65536, stream) != hipSuccess) { fprintf(stderr, "kernel_launch: memset failed\n"); return; }
    Args a{};
    for (int i = 0; i < 28; ++i) a.in[i] = (const float*)d_in[i];
    a.out = (float*)d_out; a.ws = (unsigned char*)d_ws;
#if MK_N_LAUNCHES == 1
    a.ph_lo = 0; a.ph_hi = 12;
    void* args[] = {&a};
    hipError_t e = hipLaunchCooperativeKernel((const void*)fwd_kernel, dim3(grid), dim3(NTHR), args, LDS_BYTES, stream);
    if (e != hipSuccess) fprintf(stderr, "kernel_launch: cooperative launch failed: %s (grid %d)\n", hipGetErrorString(e), grid);
#else
    for (int p = 0; p < 12; ++p) { a.ph_lo = p; a.ph_hi = p + 1; hipLaunchKernelGGL(fwd_kernel, dim3(grid), dim3(NTHR), LDS_BYTES, stream, a); }
#endif
}
```
